# Optimizing an MI355X kernel written in HIP

```python
import jax, jax.numpy as jnp
from jax import lax
import numpy as np

D_MODEL = 1024
BATCH = 8
SEQ = 4096
DEPTH = 2

N_EVEN = (DEPTH + 1) // 2
N_ODD = DEPTH // 2
RMS_EPS = 1e-5
LN_EPS = 1e-5
D_FF = 4 * D_MODEL

GM_WIDTH = D_MODEL
GM_GROUPS = 8
GM_CH = GM_WIDTH // GM_GROUPS
GM_CHUNK = 128

SSM_D_INNER = D_MODEL
SSM_HEADDIM = 64
SSM_HEADS = SSM_D_INNER // SSM_HEADDIM
SSM_GROUPS = 4
SSM_STATE = 128
SSM_CONV = 4
SSD_CHUNK = 128
SSM_CONV_DIM = SSM_D_INNER + 2 * SSM_GROUPS * SSM_STATE

IN_EVEN = 2 * GM_WIDTH + SSM_D_INNER + SSM_CONV_DIM + SSM_HEADS
MIX_EVEN = GM_WIDTH + SSM_D_INNER

ATTN_HEADS = 16
ATTN_KV_HEADS = 2
ATTN_HEAD_DIM = 64
ATTN_WINDOW = 128
ATTN_BLOCK = ATTN_WINDOW
QKV_DIM = (ATTN_HEADS + 2 * ATTN_KV_HEADS) * ATTN_HEAD_DIM

kernel_name = "hybrid_gmlp_ssd_swa_sinks"


def rmsnorm(x, g, eps=RMS_EPS):
    xf = x.astype(jnp.float32)
    y = xf * lax.rsqrt(jnp.mean(xf * xf, axis=-1, keepdims=True) + eps)
    return (y * g.astype(jnp.float32)).astype(x.dtype)


def layernorm(x, g, b, eps=LN_EPS):
    xf = x.astype(jnp.float32)
    mu = jnp.mean(xf, axis=-1, keepdims=True)
    var = jnp.mean(jnp.square(xf - mu), axis=-1, keepdims=True)
    y = (xf - mu) * lax.rsqrt(var + eps)
    return (y * g.astype(jnp.float32) + b.astype(jnp.float32)).astype(x.dtype)


def gmlp_spatial_gating(u, v, ln_g, ln_b, w_s, b_s):
    b, s, _ = v.shape
    nc = s // GM_CHUNK
    vn = layernorm(v, ln_g, ln_b).reshape(b, nc, GM_CHUNK, GM_GROUPS, GM_CH)
    causal = jnp.tril(jnp.ones((GM_CHUNK, GM_CHUNK), dtype=bool))
    w = jnp.where(causal, w_s, 0.0).astype(v.dtype)
    mixed = jnp.einsum('gts,bcsgd->bctgd', w, vn) + b_s.T[None, None, :, :, None]
    return u * mixed.reshape(b, s, GM_WIDTH)


def causal_depthwise_conv(x, w, bias):
    k = w.shape[0]
    s = x.shape[1]
    xp = jnp.pad(x, ((0, 0), (k - 1, 0), (0, 0)))
    return sum(xp[:, i:i + s] * w[i] for i in range(k)) + bias


def ssd_chunked(x, dt, a_neg, bm, cm):
    b, s, h, p = x.shape
    g, n = bm.shape[2], bm.shape[3]
    r = h // g
    l = SSD_CHUNK
    c = s // l
    xc = x.reshape(b, c, l, g, r, p)
    bc = bm.reshape(b, c, l, g, n)
    cc = cm.reshape(b, c, l, g, n)
    dtc = dt.reshape(b, c, l, g, r)
    a_cum = jnp.cumsum(dtc * a_neg.reshape(g, r), axis=2)
    causal = jnp.tril(jnp.ones((l, l), dtype=bool))[:, :, None, None]
    seg = a_cum[:, :, :, None] - a_cum[:, :, None, :]
    decay = jnp.exp(jnp.where(causal, seg, -jnp.inf))
    cb = jnp.einsum('bclgn,bcsgn->bclsg', cc, bc)
    w_intra = (cb[..., None] * decay * dtc[:, :, None]).astype(x.dtype)
    y_diag = jnp.einsum('bclsgr,bcsgrp->bclgrp', w_intra, xc)
    to_end = (jnp.exp(a_cum[:, :, -1:] - a_cum) * dtc).astype(x.dtype)
    states = jnp.einsum('bclgn,bclgr,bclgrp->bcgrpn', bc, to_end, xc)
    chunk_decay = jnp.exp(a_cum[:, :, -1]).astype(x.dtype)

    def step(hstate, inp):
        dec, st = inp
        return dec[..., None, None] * hstate + st, hstate

    h0 = jnp.zeros((b, g, r, p, n), x.dtype)
    _, prev = lax.scan(step, h0, (jnp.moveaxis(chunk_decay, 1, 0), jnp.moveaxis(states, 1, 0)))
    prev = jnp.moveaxis(prev, 0, 1)
    y_off = jnp.einsum('bclgn,bcgrpn,bclgr->bclgrp', cc, prev, jnp.exp(a_cum).astype(x.dtype))
    return (y_diag + y_off).reshape(b, s, h, p)


def ssd_mixer(z, xbc, dt_raw, conv_w, conv_b, dt_bias, a_log, d_skip, norm_g):
    b, s, _ = z.shape
    xbc = jax.nn.silu(causal_depthwise_conv(xbc, conv_w, conv_b))
    xs, bm, cm = jnp.split(xbc, [SSM_D_INNER, SSM_D_INNER + SSM_GROUPS * SSM_STATE], axis=-1)
    xs = xs.reshape(b, s, SSM_HEADS, SSM_HEADDIM)
    bm = bm.reshape(b, s, SSM_GROUPS, SSM_STATE)
    cm = cm.reshape(b, s, SSM_GROUPS, SSM_STATE)
    dt = jax.nn.softplus(dt_raw.astype(jnp.float32) + dt_bias.astype(jnp.float32))
    a_neg = -jnp.exp(a_log.astype(jnp.float32))
    y = ssd_chunked(xs, dt, a_neg, bm, cm) + xs * d_skip[:, None]
    y = y.reshape(b, s, SSM_D_INNER) * jax.nn.silu(z)
    y = rmsnorm(y.reshape(b, s, SSM_GROUPS, -1), norm_g.reshape(SSM_GROUPS, -1))
    return y.reshape(b, s, SSM_D_INNER)


def even_mixer(h, w_in, w_out, gm_ln_g, gm_ln_b, gm_w_s, gm_b_s,
               conv_w, conv_b, dt_bias, a_log, d_skip, ssm_norm_g):
    proj = h @ w_in
    u, v, z, xbc, dt_raw = jnp.split(
        proj, [GM_WIDTH, 2 * GM_WIDTH, 2 * GM_WIDTH + SSM_D_INNER,
               2 * GM_WIDTH + SSM_D_INNER + SSM_CONV_DIM], axis=-1)
    a_out = gmlp_spatial_gating(jax.nn.gelu(u), jax.nn.gelu(v), gm_ln_g, gm_ln_b, gm_w_s, gm_b_s)
    b_out = ssd_mixer(z, xbc, dt_raw, conv_w, conv_b, dt_bias, a_log, d_skip, ssm_norm_g)
    return jnp.concatenate([a_out, b_out], axis=-1) @ w_out


def sliding_window_sink_attention(q, k, v, sinks):
    b, s, _, d = q.shape
    blk = ATTN_BLOCK
    nb = s // blk
    grp = ATTN_HEADS // ATTN_KV_HEADS
    qb = q.reshape(b, nb, blk, ATTN_KV_HEADS, grp, d)
    kp = jnp.pad(k, ((0, 0), (blk, 0), (0, 0), (0, 0))).reshape(b, nb + 1, blk, ATTN_KV_HEADS, d)
    vp = jnp.pad(v, ((0, 0), (blk, 0), (0, 0), (0, 0))).reshape(b, nb + 1, blk, ATTN_KV_HEADS, d)
    kband = jnp.concatenate([kp[:, :-1], kp[:, 1:]], axis=2)
    vband = jnp.concatenate([vp[:, :-1], vp[:, 1:]], axis=2)
    scores = jnp.einsum('bnqkgd,bnskd->bnkgqs', qb, kband).astype(jnp.float32) * (d ** -0.5)
    qpos = jnp.arange(nb)[:, None, None] * blk + jnp.arange(blk)[None, :, None]
    kpos = jnp.arange(nb)[:, None, None] * blk - blk + jnp.arange(2 * blk)[None, None, :]
    rel = qpos - kpos
    valid = (rel >= 0) & (rel < ATTN_WINDOW) & (kpos >= 0)
    scores = jnp.where(valid[None, :, None, None], scores, -jnp.inf)
    sink = sinks.astype(jnp.float32).reshape(ATTN_KV_HEADS, grp)[None, None, :, :, None, None]
    m = jnp.maximum(jnp.max(scores, axis=-1, keepdims=True), sink)
    pexp = jnp.exp(scores - m)
    denom = jnp.sum(pexp, axis=-1, keepdims=True) + jnp.exp(sink - m)
    probs = (pexp / denom).astype(v.dtype)
    out = jnp.einsum('bnkgqs,bnskd->bnqkgd', probs, vband)
    return out.reshape(b, s, ATTN_HEADS * d)


def odd_mixer(h, w_qkv, b_qkv, w_o, b_o, sinks):
    b, s, _ = h.shape
    qkv = h @ w_qkv + b_qkv
    q, k, v = jnp.split(qkv, [ATTN_HEADS * ATTN_HEAD_DIM, (ATTN_HEADS + ATTN_KV_HEADS) * ATTN_HEAD_DIM], axis=-1)
    q = q.reshape(b, s, ATTN_HEADS, ATTN_HEAD_DIM)
    k = k.reshape(b, s, ATTN_KV_HEADS, ATTN_HEAD_DIM)
    v = v.reshape(b, s, ATTN_KV_HEADS, ATTN_HEAD_DIM)
    return sliding_window_sink_attention(q, k, v, sinks) @ w_o + b_o


def squared_relu_mlp(h, w_up, w_down):
    return jnp.square(jax.nn.relu(h @ w_up)) @ w_down


def setup_inputs(seed: int = 0) -> dict:
    key = jax.random.key(seed)
    ks = jax.random.split(key, 24)
    nrm = jax.random.normal
    f32 = jnp.float32
    dt0 = jnp.exp(jax.random.uniform(ks[10], (N_EVEN, SSM_HEADS), f32, np.log(1e-3), np.log(1e-1)))
    return {
        "x": nrm(ks[0], (BATCH, SEQ, D_MODEL), f32),
        "norm_mix_g": 1.0 + 0.02 * nrm(ks[1], (DEPTH, D_MODEL), f32),
        "norm_mlp_g": 1.0 + 0.02 * nrm(ks[2], (DEPTH, D_MODEL), f32),
        "final_norm_g": 1.0 + 0.02 * nrm(ks[3], (D_MODEL,), f32),
        "w_in_even": nrm(ks[4], (N_EVEN, D_MODEL, IN_EVEN), f32) * D_MODEL ** -0.5,
        "w_out_even": nrm(ks[5], (N_EVEN, MIX_EVEN, D_MODEL), f32) * MIX_EVEN ** -0.5,
        "gm_ln_g": 1.0 + 0.02 * nrm(ks[6], (N_EVEN, GM_WIDTH), f32),
        "gm_ln_b": 0.02 * nrm(ks[7], (N_EVEN, GM_WIDTH), f32),
        "gm_w_s": nrm(ks[8], (N_EVEN, GM_GROUPS, GM_CHUNK, GM_CHUNK), f32) * 0.5 * GM_CHUNK ** -0.5,
        "gm_b_s": 1.0 + 0.02 * nrm(ks[9], (N_EVEN, GM_GROUPS, GM_CHUNK), f32),
        "ssm_conv_w": nrm(ks[11], (N_EVEN, SSM_CONV, SSM_CONV_DIM), f32) * SSM_CONV ** -0.5,
        "ssm_conv_b": 0.02 * nrm(ks[12], (N_EVEN, SSM_CONV_DIM), f32),
        "ssm_dt_bias": dt0 + jnp.log(-jnp.expm1(-dt0)),
        "ssm_a_log": jnp.log(jax.random.uniform(ks[13], (N_EVEN, SSM_HEADS), f32, 1.0, 16.0)),
        "ssm_d": 1.0 + 0.1 * nrm(ks[14], (N_EVEN, SSM_HEADS), f32),
        "ssm_norm_g": 1.0 + 0.02 * nrm(ks[15], (N_EVEN, SSM_D_INNER), f32),
        "w_qkv": nrm(ks[16], (N_ODD, D_MODEL, QKV_DIM), f32) * D_MODEL ** -0.5,
        "b_qkv": 0.02 * nrm(ks[17], (N_ODD, QKV_DIM), f32),
        "w_o": nrm(ks[18], (N_ODD, ATTN_HEADS * ATTN_HEAD_DIM, D_MODEL), f32) * (ATTN_HEADS * ATTN_HEAD_DIM) ** -0.5,
        "b_o": 0.02 * nrm(ks[19], (N_ODD, D_MODEL), f32),
        "attn_sinks": 0.5 * nrm(ks[20], (N_ODD, ATTN_HEADS), f32),
        "w_up": nrm(ks[21], (DEPTH, D_MODEL, D_FF), f32) * D_MODEL ** -0.5,
        "w_down": nrm(ks[22], (DEPTH, D_FF, D_MODEL), f32) * D_FF ** -0.5,
    }


def reference(x, norm_mix_g, norm_mlp_g, final_norm_g, w_in_even, w_out_even,
              gm_ln_g, gm_ln_b, gm_w_s, gm_b_s, ssm_conv_w, ssm_conv_b,
              ssm_dt_bias, ssm_a_log, ssm_d, ssm_norm_g,
              w_qkv, b_qkv, w_o, b_o, attn_sinks, w_up, w_down):
    h = x
    for i in range(DEPTH):
        j = i // 2
        y = rmsnorm(h, norm_mix_g[i])
        if i % 2 == 0:
            h = h + even_mixer(y, w_in_even[j], w_out_even[j], gm_ln_g[j], gm_ln_b[j],
                               gm_w_s[j], gm_b_s[j], ssm_conv_w[j], ssm_conv_b[j],
                               ssm_dt_bias[j], ssm_a_log[j], ssm_d[j], ssm_norm_g[j])
        else:
            h = h + odd_mixer(y, w_qkv[j], b_qkv[j], w_o[j], b_o[j], attn_sinks[j])
        y = rmsnorm(h, norm_mlp_g[i])
        h = h + squared_relu_mlp(y, w_up[i], w_down[i])
    return rmsnorm(h, final_norm_g)
```

```cpp
#define MK_N_LAUNCHES 1
#include <hip/hip_runtime.h>
#include <hip/hip_cooperative_groups.h>
#include <cstdio>
#include <cstdint>
namespace cg = cooperative_groups;
namespace pg8 {
#define PG8_LAS __attribute__((address_space(3)))
typedef unsigned short bf16_t;
typedef short bf16x8 __attribute__((ext_vector_type(8)));
typedef float f32x4 __attribute__((ext_vector_type(4)));
typedef unsigned u32x4 __attribute__((ext_vector_type(4)));
constexpr int BM = 256, BK = 64, HALF = 128, HTB = HALF * BK * 2  , STAGE_BYTES = 8 * HTB, NXCD = 8, WGM = 8;

__host__ __device__ __forceinline__ int lds_byte(int r, int c) { const int st = (r >> 4) * 2 + (c >> 5), rr = r & 15, cc = c & 31, ob = rr * 64 + cc * 2; return st * 1024 + (ob ^ (((ob >> 9) & 1) << 5)); }
__host__ __device__ __forceinline__ void stage_rc(int b, int& R, int& C) { const int st = b / 1024, sb = b % 1024, swz = sb ^ (((sb >> 9) & 1) << 5); R = (st >> 1) * 16 + swz / 64; C = (st & 1) * 32 + (swz % 64) / 2; }
__host__ __device__ __forceinline__ int perm32(int rho) { const int n = rho >> 4, i = rho & 15; return 8 * (i >> 2) + 4 * n + (i & 3); }

struct Unit { int pm, pn; };
struct Gemm { const bf16_t* A; const bf16_t* Bt; int M, N, K; };

struct StaticOrder {
    int nM, nN, nwg, G, c;
    __host__ __device__ void init(int M, int N, int G_, int c_) { nM = M / BM; nN = N / BM; nwg = nM * nN; G = G_; c = c_; }
    __host__ __device__ bool next(int i, Unit& u) const {
        const long L = (long)i * G + c; if (L >= nwg) return false;
        int wgid = (int)L; { const int q = nwg / NXCD, r = nwg % NXCD, xcd = wgid % NXCD, off = wgid / NXCD; wgid = (xcd < r ? xcd * (q + 1) : r * (q + 1) + (xcd - r) * q) + off; }
        const int nig = WGM * nN, gid = wgid / nig, fm = gid * WGM, gsz = (nM - fm) < WGM ? (nM - fm) : WGM;
        u.pm = fm + ((wgid % nig) % gsz); u.pn = (wgid % nig) / gsz; return true;
    }
    __device__ __forceinline__ void a_ready(const Unit&) const {}
    __device__ __forceinline__ void done(const Unit&) const {}
};

__device__ __forceinline__ unsigned cvt_pk_bf16(float lo, float hi) { unsigned r; asm volatile("v_cvt_pk_bf16_f32 %0, %1, %2" : "=v"(r) : "v"(lo), "v"(hi)); return r; }
typedef float f32x2 __attribute__((ext_vector_type(2)));
template <class Epi, class Sched, bool ALIGN_EPI = false, bool SP2 = false>
__device__ __forceinline__ void gemm_phase(PG8_LAS unsigned char* lds, const Gemm g, const Sched& S, const Epi& E) {
    const int tid = threadIdx.x, wid = __builtin_amdgcn_readfirstlane(tid >> 6), lane = tid & 63, wr = wid >> 2, wc = wid & 3, fr = lane & 15, fq = lane >> 4;
    const int K = g.K, nt = K / BK;
    unsigned voffA[2], voffB[2];
#pragma unroll
    for (int i = 0; i < 2; ++i) { int R, C; stage_rc(tid * 16 + i * 8192, R, C); const int Rb = Epi::PERM ? ((R & ~31) + perm32(R & 31)) : R;
        voffA[i] = (unsigned)(R * K + C) * 2u; voffB[i] = (unsigned)(Rb * K + C) * 2u; }
    const size_t kstep = (size_t)(BK * 2);
    const size_t hstep = (size_t)HALF * K * 2;
    const size_t tstep = 2 * hstep;
    const unsigned ldsw = (unsigned)wid * 1024u;
    const int aoff = lds_byte(wr * 64 + fr, fq * 8), boff = lds_byte(wc * 32 + fr, fq * 8);
#define PG8_SA(b, h) (((b) * 2 + (h)) * HTB)
#define PG8_SB(b, h) ((4 + (b) * 2 + (h)) * HTB)
#define PG8_STAGE(bufoff, gbase, voff) do { _Pragma("unroll") for (int _i = 0; _i < 2; ++_i) \
        __builtin_amdgcn_global_load_lds((const unsigned*)((const char*)(gbase) + (voff)[_i]), (PG8_LAS unsigned*)(lds + (bufoff) + ldsw + _i * 8192), 16, 0, 0); } while (0)
#define PG8_LDA(dst, b, h) do { _Pragma("unroll") for (int m = 0; m < 4; ++m) _Pragma("unroll") for (int k = 0; k < 2; ++k) dst[m][k] = *(const PG8_LAS bf16x8*)(lds + PG8_SA(b, h) + aoff + m * 2048 + k * 1024); } while (0)
#define PG8_LDB(dst, b, h) do { _Pragma("unroll") for (int n = 0; n < 2; ++n) _Pragma("unroll") for (int k = 0; k < 2; ++k) dst[n][k] = *(const PG8_LAS bf16x8*)(lds + PG8_SB(b, h) + boff + n * 2048 + k * 1024); } while (0)
#define PG8_MMA(ai, bj, At, Bt) do { __builtin_amdgcn_s_setprio(1); _Pragma("unroll") for (int m = 0; m < 4; ++m) _Pragma("unroll") for (int n = 0; n < 2; ++n) _Pragma("unroll") for (int k = 0; k < 2; ++k) \
        acc[ai][bj][m][n] = __builtin_amdgcn_mfma_f32_16x16x32_bf16(Bt[n][k], At[m][k], acc[ai][bj][m][n], 0, 0, 0); __builtin_amdgcn_s_setprio(0); } while (0)
#define PG8_WAIT_V(n) asm volatile("s_waitcnt vmcnt(" #n ")" ::: "memory")
#define PG8_WAIT_L(n) asm volatile("s_waitcnt lgkmcnt(" #n ")" ::: "memory")
#define PG8_BAR __builtin_amdgcn_s_barrier()
#define PG8_SCHED __builtin_amdgcn_sched_barrier(0)
    Unit cur, nxt; int ui = 0;
    if (!S.next(0, cur)) return;
    f32x4 acc[2][2][4][2];
#pragma unroll
    for (int a = 0; a < 2; ++a)
#pragma unroll
        for (int b = 0; b < 2; ++b)
#pragma unroll
            for (int m = 0; m < 4; ++m)
#pragma unroll
                for (int n = 0; n < 2; ++n) acc[a][b][m][n] = (f32x4){0.f, 0.f, 0.f, 0.f};
    bf16x8 At[4][2], B0[2][2], B1[2][2];
    const char* cA = (const char*)g.A + (size_t)cur.pm * tstep; const char* cB = (const char*)g.Bt + (size_t)cur.pn * tstep;
    S.a_ready(cur);
    if constexpr (SP2) {
        PG8_STAGE(PG8_SB(0, 0), cB, voffB); PG8_STAGE(PG8_SB(0, 1), cB + hstep, voffB); PG8_STAGE(PG8_SA(0, 0), cA, voffA); PG8_STAGE(PG8_SA(0, 1), cA + hstep, voffA);
        if (wr == 1) PG8_BAR;
        PG8_WAIT_V(2); PG8_BAR;
        PG8_STAGE(PG8_SB(1, 0), cB + kstep, voffB); PG8_STAGE(PG8_SA(1, 0), cA + kstep, voffA); PG8_STAGE(PG8_SB(1, 1), cB + hstep + kstep, voffB);
        PG8_WAIT_V(6); PG8_BAR;
    } else {
        PG8_STAGE(PG8_SB(0, 0), cB, voffB); PG8_STAGE(PG8_SA(0, 0), cA, voffA); PG8_STAGE(PG8_SB(0, 1), cB + hstep, voffB); PG8_STAGE(PG8_SA(0, 1), cA + hstep, voffA);
        if (wr == 1) PG8_BAR;
        PG8_WAIT_V(4); PG8_BAR;
        PG8_STAGE(PG8_SB(1, 0), cB + kstep, voffB); PG8_STAGE(PG8_SA(1, 0), cA + kstep, voffA); PG8_STAGE(PG8_SB(1, 1), cB + hstep + kstep, voffB);
        PG8_WAIT_V(6); PG8_BAR;
    }
    for (;;) {
        const bool has_next = S.next(ui + 1, nxt);
        const char* nA = has_next ? (const char*)g.A + (size_t)nxt.pm * tstep : cA; const char* nB = has_next ? (const char*)g.Bt + (size_t)nxt.pn * tstep : cB;
        for (int t = 0; t < nt; t += 2) {
            const bool last = (t == nt - 2);
            const char* a1 = cA + (size_t)(t + 1) * kstep;
            const char* a2 = last ? nA : cA + (size_t)(t + 2) * kstep; const char* b2 = last ? nB : cB + (size_t)(t + 2) * kstep;
            const char* a3 = a2 + kstep; const char* b3 = b2 + kstep;
            if (last && has_next) S.a_ready(nxt);
            if constexpr (SP2) {
            PG8_LDB(B0, 0, 0); PG8_LDB(B1, 0, 1); PG8_SCHED; PG8_LDA(At, 0, 0); PG8_STAGE(PG8_SA(1, 1), a1 + hstep, voffA);
            PG8_WAIT_V(8); PG8_WAIT_L(0); PG8_BAR; PG8_MMA(0, 0, At, B0); PG8_MMA(0, 1, At, B1); PG8_BAR; PG8_SCHED;
            PG8_LDA(At, 0, 1); PG8_STAGE(PG8_SB(0, 0), b2, voffB); PG8_STAGE(PG8_SB(0, 1), b2 + hstep, voffB); PG8_STAGE(PG8_SA(0, 0), a2, voffA);
            PG8_WAIT_V(8); PG8_WAIT_L(0); PG8_BAR; PG8_MMA(1, 0, At, B0); PG8_MMA(1, 1, At, B1); PG8_BAR; PG8_SCHED;
            PG8_LDB(B0, 1, 0); PG8_LDB(B1, 1, 1); PG8_SCHED; PG8_LDA(At, 1, 0); PG8_STAGE(PG8_SA(0, 1), a2 + hstep, voffA);
            PG8_WAIT_V(8); PG8_WAIT_L(0); PG8_BAR; PG8_MMA(0, 0, At, B0); PG8_MMA(0, 1, At, B1); PG8_BAR; PG8_SCHED;
            PG8_LDA(At, 1, 1); PG8_STAGE(PG8_SB(1, 0), b3, voffB); PG8_STAGE(PG8_SB(1, 1), b3 + hstep, voffB); PG8_STAGE(PG8_SA(1, 0), a3, voffA);
            PG8_WAIT_V(8); PG8_WAIT_L(0); PG8_BAR; PG8_MMA(1, 0, At, B0); PG8_MMA(1, 1, At, B1); PG8_BAR; PG8_SCHED;
            } else {
            PG8_LDB(B0, 0, 0); PG8_SCHED; PG8_LDA(At, 0, 0); PG8_STAGE(PG8_SA(1, 1), a1 + hstep, voffA);
            PG8_WAIT_L(8); PG8_BAR; PG8_WAIT_L(0); PG8_MMA(0, 0, At, B0); PG8_BAR; PG8_SCHED;
            PG8_LDB(B1, 0, 1); PG8_STAGE(PG8_SB(0, 0), b2, voffB);
            PG8_BAR; PG8_WAIT_L(0); PG8_MMA(0, 1, At, B1); PG8_BAR;
            PG8_LDA(At, 0, 1); PG8_STAGE(PG8_SA(0, 0), a2, voffA);
            PG8_BAR; PG8_WAIT_L(0); PG8_MMA(1, 0, At, B0); PG8_BAR; PG8_SCHED;
            PG8_STAGE(PG8_SB(0, 1), b2 + hstep, voffB);
            PG8_WAIT_V(6); PG8_BAR; PG8_MMA(1, 1, At, B1); PG8_BAR;
            PG8_LDB(B0, 1, 0); PG8_SCHED; PG8_LDA(At, 1, 0); PG8_STAGE(PG8_SA(0, 1), a2 + hstep, voffA);
            PG8_WAIT_L(8); PG8_BAR; PG8_WAIT_L(0); PG8_MMA(0, 0, At, B0); PG8_BAR; PG8_SCHED;
            PG8_LDB(B1, 1, 1); PG8_STAGE(PG8_SB(1, 0), b3, voffB);
            PG8_BAR; PG8_WAIT_L(0); PG8_MMA(0, 1, At, B1); PG8_BAR;
            PG8_LDA(At, 1, 1); PG8_STAGE(PG8_SA(1, 0), a3, voffA);
            PG8_BAR; PG8_WAIT_L(0); PG8_MMA(1, 0, At, B0); PG8_BAR; PG8_SCHED;
            PG8_STAGE(PG8_SB(1, 1), b3 + hstep, voffB);
            PG8_WAIT_V(6); PG8_BAR; PG8_MMA(1, 1, At, B1); PG8_BAR;
            }
        }
        if constexpr (ALIGN_EPI) { if (wr == 0) PG8_BAR; }
        if constexpr (!Epi::AFTER_DRAIN) { E(acc, cur, wr, wc, fr, fq); S.done(cur); }
        if (!has_next) break;
#pragma unroll
        for (int a = 0; a < 2; ++a)
#pragma unroll
            for (int b = 0; b < 2; ++b)
#pragma unroll
                for (int m = 0; m < 4; ++m)
#pragma unroll
                    for (int n = 0; n < 2; ++n) acc[a][b][m][n] = (f32x4){0.f, 0.f, 0.f, 0.f};
        cur = nxt; cA = nA; cB = nB; ++ui;
        if constexpr (ALIGN_EPI) { if (wr == 1) PG8_BAR; }
    }
    PG8_WAIT_V(0);
    if constexpr (!ALIGN_EPI) { if (wr == 0) PG8_BAR; }
    PG8_BAR;
    if constexpr (Epi::AFTER_DRAIN) { E.fused(acc, cur, wr, wc, fr, fq, lds, wid, lane); S.done(cur); }
#undef PG8_SA
#undef PG8_SB
#undef PG8_STAGE
#undef PG8_LDA
#undef PG8_LDB
#undef PG8_MMA
#undef PG8_WAIT_V
#undef PG8_WAIT_L
#undef PG8_BAR
#undef PG8_SCHED
}
}

#define LAS __attribute__((address_space(3)))
typedef unsigned short bf16;
typedef unsigned u32x4 __attribute__((ext_vector_type(4)));
typedef unsigned u32x2 __attribute__((ext_vector_type(2)));
typedef float f32x4 __attribute__((ext_vector_type(4)));
typedef float f32x2 __attribute__((ext_vector_type(2)));
typedef short bf16x8 __attribute__((ext_vector_type(8)));
#define LDS_WAIT() asm volatile("s_waitcnt lgkmcnt(0)" ::: "memory")

constexpr int MTOK = 32768, DM = 1024, DFF = 4096, QKVD = 1280, INEV = 5136, NPROJ = 5120;
constexpr size_t MiB = 1u << 20;
constexpr size_t WS_WGM = 1 * MiB, WS_WIN = 2 * MiB, WS_WOUT = 12 * MiB, WS_WUP0 = 16 * MiB, WS_WUP1 = 24 * MiB, WS_WDN0 = 32 * MiB, WS_WDN1 = 40 * MiB,
                 WS_WQKV = 48 * MiB, WS_WO = 51 * MiB, WS_DT = 53 * MiB, WS_SSP = 55 * MiB, WS_LNP = 57 * MiB, WS_DEC = 61 * MiB, WS_XB = 62 * MiB, WS_ST = 126 * MiB,
                 WS_MIX = 190 * MiB, WS_GV = 318 * MiB, WS_XBC = 382 * MiB, WS_HID = 190 * MiB, WS_QKV = 190 * MiB, WS_ATT = 270 * MiB, WS_END = 510 * MiB;
constexpr int LDS_BYTES = 147456;
constexpr int NPHASE = 14;

typedef __bf16 bf16x2_t __attribute__((ext_vector_type(2)));
__device__ __forceinline__ unsigned pk2(float lo, float hi) { const f32x2 v = {lo, hi}; const bf16x2_t b = __builtin_convertvector(v, bf16x2_t); return __builtin_bit_cast(unsigned, b); }
__device__ __forceinline__ float bflo(unsigned u) { return __uint_as_float(u << 16); }
__device__ __forceinline__ float bfhi(unsigned u) { return __uint_as_float(u & 0xffff0000u); }
__device__ __forceinline__ float ex(float x) { return __builtin_amdgcn_exp2f(x * 1.4426950408889634f); }
__device__ __forceinline__ float rcp(float x) { return __builtin_amdgcn_rcpf(x); }
__device__ __forceinline__ float gelu_t(float x) { const float u = 1.5957691216057308f * (x + 0.044715f * x * x * x); return x * rcp(1.f + ex(-u)); }
__device__ __forceinline__ float silu(float x) { return x * rcp(1.f + ex(-x)); }
__device__ __forceinline__ f32x4 mma(f32x4 acc, bf16x8 a, bf16x8 b) { return __builtin_amdgcn_mfma_f32_16x16x32_bf16(b, a, acc, 0, 0, 0); }
__device__ __forceinline__ bf16x8 lds128(LAS unsigned char* lds, int byteoff) { return *(const LAS bf16x8*)(lds + byteoff); }
__device__ __forceinline__ void st16(LAS unsigned char* lds, int byteoff, unsigned v) { *(LAS unsigned short*)(lds + byteoff) = (unsigned short)v; }

struct Args { const float* in[23]; float* out; unsigned char* ws; int ph_lo, ph_hi; };

__device__ __forceinline__ float row_rstd(const float* ssp, size_t row, int fq) {
    const f32x4 p = *(const f32x4*)(ssp + row * 16 + fq * 4);
    float s = (p.x + p.y) + (p.z + p.w);
    s += __shfl_xor(s, 16); s += __shfl_xor(s, 32);
    return rsqrtf(s * (1.f / 1024.f) + 1e-5f);
}
struct EpiInProj {
    static constexpr bool PERM = true, AFTER_DRAIN = false;
    const float* ssp; bf16* mix; bf16* gv; bf16* xbc; float* lnp;
    __device__ __forceinline__ void operator()(const f32x4 (&acc)[2][2][4][2], const pg8::Unit& u, int wr, int wc, int fr, int fq) const {
        const size_t row0 = (size_t)u.pm * 256 + wr * 64 + fr; const int cl = wc * 32 + 8 * fq; const int pn = u.pn;
        bf16* dst; int ld; bool act = false, stats = false;
        if (pn < 4) { dst = mix + pn * 256; ld = 2048; act = true; }
        else if (pn < 8) { dst = gv + (pn - 4) * 256; ld = 1024; act = true; stats = true; }
        else if (pn < 12) { dst = mix + 1024 + (pn - 8) * 256; ld = 2048; }
        else { dst = xbc + (pn - 12) * 256; ld = 2048; }
#pragma unroll
        for (int ai = 0; ai < 2; ++ai)
#pragma unroll
            for (int m = 0; m < 4; ++m) {
                const size_t row = row0 + ai * 128 + m * 16; const float rs = row_rstd(ssp, row, fq);
                float s1 = 0.f, s2 = 0.f;
#pragma unroll
                for (int bj = 0; bj < 2; ++bj) {
                    f32x4 v0 = acc[ai][bj][m][0] * rs, v1 = acc[ai][bj][m][1] * rs;
                    if (act) {
#pragma unroll
                        for (int j = 0; j < 4; ++j) { v0[j] = gelu_t(v0[j]); v1[j] = gelu_t(v1[j]); }
                    }
                    if (stats) {
#pragma unroll
                        for (int j = 0; j < 4; ++j) { s1 += v0[j] + v1[j]; s2 += v0[j] * v0[j] + v1[j] * v1[j]; }
                    }
                    u32x4 w; w.x = pk2(v0[0], v0[1]); w.y = pk2(v0[2], v0[3]); w.z = pk2(v1[0], v1[1]); w.w = pk2(v1[2], v1[3]);
                    *(u32x4*)(dst + row * ld + bj * 128 + cl) = w;
                }
                if (stats) {
                    s1 += __shfl_xor(s1, 16); s1 += __shfl_xor(s1, 32); s2 += __shfl_xor(s2, 16); s2 += __shfl_xor(s2, 32);
                    if (fq == 0) { f32x2 o; o.x = s1; o.y = s2; *(f32x2*)(lnp + (row * 16 + (pn - 4) * 4 + wc) * 2) = o; }
                }
            }
    }
};
struct EpiResid {
    static constexpr bool PERM = true, AFTER_DRAIN = false;
    bf16* xb; float* ssp; const float* bias;
    __device__ __forceinline__ void operator()(const f32x4 (&acc)[2][2][4][2], const pg8::Unit& u, int wr, int wc, int fr, int fq) const {
        const size_t row0 = (size_t)u.pm * 256 + wr * 64 + fr; const int col0 = u.pn * 256 + wc * 32 + 8 * fq;
        f32x4 bv[2][2];
#pragma unroll
        for (int bj = 0; bj < 2; ++bj)
#pragma unroll
            for (int n = 0; n < 2; ++n) bv[bj][n] = bias ? *(const f32x4*)(bias + col0 + bj * 128 + 4 * n) : (f32x4){0.f, 0.f, 0.f, 0.f};
#pragma unroll
        for (int ai = 0; ai < 2; ++ai)
#pragma unroll
            for (int m = 0; m < 4; ++m) {
                const size_t row = row0 + ai * 128 + m * 16; float ss = 0.f;
#pragma unroll
                for (int bj = 0; bj < 2; ++bj) {
                    const size_t off = row * 1024 + col0 + bj * 128;
                    const u32x4 rv = *(const u32x4*)(xb + off);
                    f32x4 v0 = acc[ai][bj][m][0] + bv[bj][0], v1 = acc[ai][bj][m][1] + bv[bj][1];
                    v0[0] += bflo(rv.x); v0[1] += bfhi(rv.x); v0[2] += bflo(rv.y); v0[3] += bfhi(rv.y); v1[0] += bflo(rv.z); v1[1] += bfhi(rv.z); v1[2] += bflo(rv.w); v1[3] += bfhi(rv.w);
#pragma unroll
                    for (int j = 0; j < 4; ++j) ss += v0[j] * v0[j] + v1[j] * v1[j];
                    u32x4 w; w.x = pk2(v0[0], v0[1]); w.y = pk2(v0[2], v0[3]); w.z = pk2(v1[0], v1[1]); w.w = pk2(v1[2], v1[3]);
                    *(u32x4*)(xb + off) = w;
                }
                ss += __shfl_xor(ss, 16); ss += __shfl_xor(ss, 32);
                if (fq == 0) ssp[row * 16 + u.pn * 4 + wc] = ss;
            }
    }
};
struct EpiRelu2 {
    static constexpr bool PERM = true, AFTER_DRAIN = false;
    const float* ssp; bf16* hid;
    __device__ __forceinline__ void operator()(const f32x4 (&acc)[2][2][4][2], const pg8::Unit& u, int wr, int wc, int fr, int fq) const {
        const size_t row0 = (size_t)u.pm * 256 + wr * 64 + fr; const int col0 = u.pn * 256 + wc * 32 + 8 * fq;
#pragma unroll
        for (int ai = 0; ai < 2; ++ai)
#pragma unroll
            for (int m = 0; m < 4; ++m) {
                const size_t row = row0 + ai * 128 + m * 16; const float rs = row_rstd(ssp, row, fq);
#pragma unroll
                for (int bj = 0; bj < 2; ++bj) {
                    f32x4 v0 = acc[ai][bj][m][0] * rs, v1 = acc[ai][bj][m][1] * rs;
#pragma unroll
                    for (int j = 0; j < 4; ++j) { const float a = fmaxf(v0[j], 0.f), b = fmaxf(v1[j], 0.f); v0[j] = a * a; v1[j] = b * b; }
                    u32x4 w; w.x = pk2(v0[0], v0[1]); w.y = pk2(v0[2], v0[3]); w.z = pk2(v1[0], v1[1]); w.w = pk2(v1[2], v1[3]);
                    *(u32x4*)(hid + row * DFF + col0 + bj * 128) = w;
                }
            }
    }
};
struct EpiQKV {
    static constexpr bool PERM = true, AFTER_DRAIN = false;
    const float* ssp; bf16* o; const float* bias;
    __device__ __forceinline__ void operator()(const f32x4 (&acc)[2][2][4][2], const pg8::Unit& u, int wr, int wc, int fr, int fq) const {
        const size_t row0 = (size_t)u.pm * 256 + wr * 64 + fr; const int col0 = u.pn * 256 + wc * 32 + 8 * fq;
        f32x4 bv[2][2];
#pragma unroll
        for (int bj = 0; bj < 2; ++bj)
#pragma unroll
            for (int n = 0; n < 2; ++n) bv[bj][n] = *(const f32x4*)(bias + col0 + bj * 128 + 4 * n);
#pragma unroll
        for (int ai = 0; ai < 2; ++ai)
#pragma unroll
            for (int m = 0; m < 4; ++m) {
                const size_t row = row0 + ai * 128 + m * 16; const float rs = row_rstd(ssp, row, fq);
#pragma unroll
                for (int bj = 0; bj < 2; ++bj) {
                    const f32x4 v0 = acc[ai][bj][m][0] * rs + bv[bj][0], v1 = acc[ai][bj][m][1] * rs + bv[bj][1];
                    u32x4 w; w.x = pk2(v0[0], v0[1]); w.y = pk2(v0[2], v0[3]); w.z = pk2(v1[0], v1[1]); w.w = pk2(v1[2], v1[3]);
                    *(u32x4*)(o + row * QKVD + col0 + bj * 128) = w;
                }
            }
    }
};

__device__ __forceinline__ void p0_transpose_item(const float* __restrict__ W, int ldw, int K, int nblk, bf16* WT, const float* __restrict__ gain, LAS float* scr, int item, int lane) {
    const int kb = item / nblk, nb = item % nblk, k0 = 64 * kb, n0 = 32 * nb;
#pragma unroll
    for (int i = 0; i < 32; ++i) { const int kk = 2 * i + (lane >> 5); const float gs = gain ? gain[k0 + kk] : 1.f; scr[kk * 33 + (lane & 31)] = W[(size_t)(k0 + kk) * ldw + n0 + (lane & 31)] * gs; }
    LDS_WAIT(); asm volatile("" ::: "memory");
    const int c = lane & 7;
#pragma unroll
    for (int j = 0; j < 4; ++j) { const int n = (lane >> 3) + 8 * j; const LAS float* s = scr + (8 * c) * 33 + n;
        u32x4 o; o.x = pk2(s[0 * 33], s[1 * 33]); o.y = pk2(s[2 * 33], s[3 * 33]); o.z = pk2(s[4 * 33], s[5 * 33]); o.w = pk2(s[6 * 33], s[7 * 33]);
        *(u32x4*)(WT + (size_t)(n0 + n) * K + k0 + 8 * c) = o; }
    LDS_WAIT(); asm volatile("" ::: "memory");
}

__device__ __forceinline__ void phase0(const Args& a, LAS unsigned char* lds, int tid, int lane, int wave, int G) {
    const float* x = a.in[0]; const float* g_mix = a.in[1]; const float* g_mlp = a.in[2]; const float* w_in = a.in[4]; const float* w_out = a.in[5];
    const float* gm_w = a.in[8]; const float* dt_bias = a.in[12]; const float* w_qkv = a.in[16]; const float* w_o = a.in[18]; const float* w_up = a.in[21]; const float* w_dn = a.in[22];
    unsigned char* ws = a.ws;
    bf16* XB = (bf16*)(ws + WS_XB); float* DT = (float*)(ws + WS_DT); float* SSP = (float*)(ws + WS_SSP);
    for (int idx = tid; idx < 16384; idx += 512) { const int k = idx >> 4, j = idx & 15; const float v = w_in[(size_t)k * INEV + NPROJ + j] * g_mix[k]; st16(lds, (j * 1032 + k) * 2, pk2(v, v)); }
    __syncthreads();
    const int gw = blockIdx.x * 8 + wave, NGW = G * 8;
    for (int item = gw; item < MTOK / 16; item += NGW) {
        const int r = lane & 15, q = lane >> 4; const size_t row = (size_t)item * 16 + r;
        const float* xp = x + row * DM + q * 8; bf16* xo = XB + row * DM + q * 8;
        f32x4 acc = {0.f, 0.f, 0.f, 0.f}; float ss = 0.f;
#pragma unroll 8
        for (int kk = 0; kk < 32; ++kk) {
            const f32x4 v0 = *(const f32x4*)(xp + kk * 32), v1 = *(const f32x4*)(xp + kk * 32 + 4);
            ss += (v0.x * v0.x + v0.y * v0.y) + (v0.z * v0.z + v0.w * v0.w) + (v1.x * v1.x + v1.y * v1.y) + (v1.z * v1.z + v1.w * v1.w);
            u32x4 w; w.x = pk2(v0.x, v0.y); w.y = pk2(v0.z, v0.w); w.z = pk2(v1.x, v1.y); w.w = pk2(v1.z, v1.w);
            *(u32x4*)(xo + kk * 32) = w;
            const bf16x8 bfr = lds128(lds, (r * 1032 + kk * 32 + q * 8) * 2);
            acc = mma(acc, __builtin_bit_cast(bf16x8, w), bfr);
        }
        ss += __shfl_xor(ss, 16); ss += __shfl_xor(ss, 32);
        const float rstd = rsqrtf(ss * (1.f / 1024.f) + 1e-5f);
        const f32x4 bias = *(const f32x4*)(dt_bias + q * 4);
        f32x4 o;
#pragma unroll
        for (int j = 0; j < 4; ++j) { const float v = acc[j] * rstd + bias[j]; o[j] = v > 20.f ? v : log1pf(expf(v)); }
        *(f32x4*)(DT + row * 16 + q * 4) = o;
        f32x4 sp = {q == 0 ? ss : 0.f, 0.f, 0.f, 0.f};
        *(f32x4*)(SSP + row * 16 + q * 4) = sp;
    }
    __syncthreads();
    LAS float* scr = (LAS float*)(lds + wave * 16384);
    constexpr int I_IN = 16 * 160, I_OUT = 32 * 32, I_UP = 16 * 128, I_DN = 64 * 32, I_QKV = 16 * 40, I_O = 16 * 32;
    constexpr int NITEMS = I_IN + I_OUT + 2 * I_UP + 2 * I_DN + I_QKV + I_O;
    for (int it = gw; it < NITEMS; it += NGW) {
        int r = it;
        if (r < I_IN) { p0_transpose_item(w_in, INEV, 1024, 160, (bf16*)(ws + WS_WIN), g_mix, scr, r, lane); continue; } r -= I_IN;
        if (r < I_OUT) { p0_transpose_item(w_out, 1024, 2048, 32, (bf16*)(ws + WS_WOUT), nullptr, scr, r, lane); continue; } r -= I_OUT;
        if (r < I_UP) { p0_transpose_item(w_up, 4096, 1024, 128, (bf16*)(ws + WS_WUP0), g_mlp, scr, r, lane); continue; } r -= I_UP;
        if (r < I_UP) { p0_transpose_item(w_up + (size_t)1024 * 4096, 4096, 1024, 128, (bf16*)(ws + WS_WUP1), g_mlp + 1024, scr, r, lane); continue; } r -= I_UP;
        if (r < I_DN) { p0_transpose_item(w_dn, 1024, 4096, 32, (bf16*)(ws + WS_WDN0), nullptr, scr, r, lane); continue; } r -= I_DN;
        if (r < I_DN) { p0_transpose_item(w_dn + (size_t)4096 * 1024, 1024, 4096, 32, (bf16*)(ws + WS_WDN1), nullptr, scr, r, lane); continue; } r -= I_DN;
        if (r < I_QKV) { p0_transpose_item(w_qkv, 1280, 1024, 40, (bf16*)(ws + WS_WQKV), g_mix + 1024, scr, r, lane); continue; } r -= I_QKV;
        p0_transpose_item(w_o, 1024, 1024, 32, (bf16*)(ws + WS_WO), nullptr, scr, r, lane);
    }
    bf16* WGM = (bf16*)(ws + WS_WGM);
    for (int idx = blockIdx.x * 512 + tid; idx < 8 * 128 * 128; idx += G * 512) { const int t = (idx >> 7) & 127, s = idx & 127; const float v = (s <= t) ? gm_w[idx] : 0.f; WGM[idx] = (bf16)(pk2(v, v) & 0xffffu); }
}

__device__ __forceinline__ void conv8(const bf16* __restrict__ XBC, size_t grow0, int l, bool first, int col, const float* __restrict__ cw, const float* __restrict__ cb, float (&o)[8]) {
    const f32x4 b0 = *(const f32x4*)(cb + col), b1 = *(const f32x4*)(cb + col + 4);
    o[0] = b0.x; o[1] = b0.y; o[2] = b0.z; o[3] = b0.w; o[4] = b1.x; o[5] = b1.y; o[6] = b1.z; o[7] = b1.w;
#pragma unroll
    for (int tap = 0; tap < 4; ++tap) {
        const int t = l - 3 + tap;
        u32x4 v = {0u, 0u, 0u, 0u};
        if (!first || t >= 0) v = *(const u32x4*)(XBC + (size_t)((long)grow0 + t) * 2048 + col);
        const f32x4 w0 = *(const f32x4*)(cw + tap * 2048 + col), w1 = *(const f32x4*)(cw + tap * 2048 + col + 4);
        o[0] += w0.x * bflo(v.x); o[1] += w0.y * bfhi(v.x); o[2] += w0.z * bflo(v.y); o[3] += w0.w * bfhi(v.y);
        o[4] += w1.x * bflo(v.z); o[5] += w1.y * bfhi(v.z); o[6] += w1.z * bflo(v.w); o[7] += w1.w * bfhi(v.w);
    }
#pragma unroll
    for (int e = 0; e < 8; ++e) o[e] = silu(o[e]);
}
__device__ __forceinline__ void conv8x8(const bf16* __restrict__ XBC, size_t grow0, int l0, bool first, int col, const float* __restrict__ cw, const float* __restrict__ cb, float (&o)[8][8]) {
    float w[4][8];
#pragma unroll
    for (int tap = 0; tap < 4; ++tap) { const f32x4 w0 = *(const f32x4*)(cw + tap * 2048 + col), w1 = *(const f32x4*)(cw + tap * 2048 + col + 4);
        w[tap][0] = w0.x; w[tap][1] = w0.y; w[tap][2] = w0.z; w[tap][3] = w0.w; w[tap][4] = w1.x; w[tap][5] = w1.y; w[tap][6] = w1.z; w[tap][7] = w1.w; }
    { const f32x4 b0 = *(const f32x4*)(cb + col), b1 = *(const f32x4*)(cb + col + 4);
#pragma unroll
      for (int j = 0; j < 8; ++j) { o[j][0] = b0.x; o[j][1] = b0.y; o[j][2] = b0.z; o[j][3] = b0.w; o[j][4] = b1.x; o[j][5] = b1.y; o[j][6] = b1.z; o[j][7] = b1.w; } }
#pragma unroll
    for (int rr = 0; rr < 11; ++rr) {
        const int t = l0 - 3 + rr;
        u32x4 v = {0u, 0u, 0u, 0u};
        if (!first || t >= 0) v = *(const u32x4*)(XBC + (size_t)((long)grow0 + t) * 2048 + col);
        float x[8];
        x[0] = bflo(v.x); x[1] = bfhi(v.x); x[2] = bflo(v.y); x[3] = bfhi(v.y); x[4] = bflo(v.z); x[5] = bfhi(v.z); x[6] = bflo(v.w); x[7] = bfhi(v.w);
#pragma unroll
        for (int tap = 0; tap < 4; ++tap) { const int j = rr - tap; if (j >= 0 && j < 8) {
#pragma unroll
            for (int e = 0; e < 8; ++e) o[j][e] += w[tap][e] * x[e]; } }
    }
#pragma unroll
    for (int j = 0; j < 8; ++j)
#pragma unroll
        for (int e = 0; e < 8; ++e) o[j][e] = silu(o[j][e]);
}
__device__ __forceinline__ float ssd_scan(const float* __restrict__ DT, const float* __restrict__ a_log, size_t grow0, int h, int r, int lane, LAS float* acum, LAS float* dts, float& a0o, float& a1o, float& d0o, float& d1o) {
    const float A = -expf(a_log[h]);
    const float d0 = DT[(grow0 + 2 * lane) * 16 + h], d1 = DT[(grow0 + 2 * lane + 1) * 16 + h];
    const float v0 = d0 * A, v1 = d1 * A, s = v0 + v1;
    float inc = s;
#pragma unroll
    for (int o = 1; o < 64; o <<= 1) { const float t = __shfl_up(inc, o); if (lane >= o) inc += t; }
    const float exc = inc - s, a0 = exc + v0, a1 = exc + s;
    acum[r * 128 + 2 * lane] = a0; acum[r * 128 + 2 * lane + 1] = a1; dts[r * 128 + 2 * lane] = d0; dts[r * 128 + 2 * lane + 1] = d1;
    a0o = a0; a1o = a1; d0o = d0; d1o = d1;
    return __shfl(a1, 63);
}

__device__ __forceinline__ void ssd_a_tile(const Args& a, LAS unsigned char* lds, int tile, int tid, int lane, int wave) {
    { int tz; asm volatile("v_mov_b32 %0, 0" : "=v"(tz)); tid += tz; lane += tz; }
    constexpr int XST = 0, BT = 69632, ACUM = 104448, DTS = ACUM + 2048, TOE = DTS + 2048;
    const int g = tile & 3, bc = tile >> 2, c = bc & 31; const size_t grow0 = (size_t)bc * 128;
    unsigned char* ws = a.ws; const bf16* XBC = (const bf16*)(ws + WS_XBC); const float* DT = (const float*)(ws + WS_DT); float* DEC = (float*)(ws + WS_DEC); bf16* ST = (bf16*)(ws + WS_ST);
    const float* cw = a.in[10]; const float* cb = a.in[11]; const float* a_log = a.in[13];
    if (wave < 4) {
        float a0, a1, d0, d1; const float tot = ssd_scan(DT, a_log, grow0, g * 4 + wave, wave, lane, (LAS float*)(lds + ACUM), (LAS float*)(lds + DTS), a0, a1, d0, d1);
        LAS float* toe = (LAS float*)(lds + TOE);
        toe[wave * 128 + 2 * lane] = ex(tot - a0) * d0; toe[wave * 128 + 2 * lane + 1] = ex(tot - a1) * d1;
        if (lane == 0) DEC[bc * 16 + g * 4 + wave] = ex(tot);
    }
    __syncthreads();
    {
        const bool first = (c == 0);
        float o[8][8];
        {
            const int chg = tid & 31, l0 = (tid >> 5) * 8;
            conv8x8(XBC, grow0, l0, first, g * 256 + chg * 8, cw, cb, o);
            const LAS float* toe = (const LAS float*)(lds + TOE) + (chg >> 3) * 128 + l0;
            const f32x4 t0 = *(const LAS f32x4*)toe, t1 = *(const LAS f32x4*)(toe + 4);
#pragma unroll
            for (int e = 0; e < 8; ++e) {
                u32x4 w; w.x = pk2(o[0][e] * t0.x, o[1][e] * t0.y); w.y = pk2(o[2][e] * t0.z, o[3][e] * t0.w); w.z = pk2(o[4][e] * t1.x, o[5][e] * t1.y); w.w = pk2(o[6][e] * t1.z, o[7][e] * t1.w);
                *(LAS u32x4*)(lds + XST + ((chg * 8 + e) * 136 + l0) * 2) = w;
            }
        }
        if (tid < 256) {
            const int chg = tid & 15, l0 = (tid >> 4) * 8;
            conv8x8(XBC, grow0, l0, first, 1024 + g * 128 + chg * 8, cw, cb, o);
#pragma unroll
            for (int e = 0; e < 8; ++e) {
                u32x4 w; w.x = pk2(o[0][e], o[1][e]); w.y = pk2(o[2][e], o[3][e]); w.z = pk2(o[4][e], o[5][e]); w.w = pk2(o[6][e], o[7][e]);
                *(LAS u32x4*)(lds + BT + ((chg * 8 + e) * 136 + l0) * 2) = w;
            }
        }
    }
    __syncthreads();
    {
        const int r = wave >> 1, ph = wave & 1, lr = lane & 15, q = lane >> 4;
        f32x4 acc[2][8];
#pragma unroll
        for (int mt = 0; mt < 2; ++mt)
#pragma unroll
            for (int nt = 0; nt < 8; ++nt) acc[mt][nt] = (f32x4){0.f, 0.f, 0.f, 0.f};
#pragma unroll
        for (int ks = 0; ks < 4; ++ks) {
            bf16x8 af[2];
#pragma unroll
            for (int mt = 0; mt < 2; ++mt) af[mt] = lds128(lds, XST + ((r * 64 + ph * 32 + mt * 16 + lr) * 136 + ks * 32 + q * 8) * 2);
#pragma unroll
            for (int nt = 0; nt < 8; ++nt) {
                const bf16x8 bfr = lds128(lds, BT + ((nt * 16 + lr) * 136 + ks * 32 + q * 8) * 2);
#pragma unroll
                for (int mt = 0; mt < 2; ++mt) acc[mt][nt] = mma(acc[mt][nt], af[mt], bfr);
            }
        }
        bf16* stp = ST + ((size_t)bc * 16 + g * 4 + r) * 8192;
#pragma unroll
        for (int mt = 0; mt < 2; ++mt)
#pragma unroll
            for (int nt = 0; nt < 8; ++nt) {
                const int p = ph * 32 + mt * 16 + lr, n = nt * 16 + q * 4;
                u32x2 w; w.x = pk2(acc[mt][nt][0], acc[mt][nt][1]); w.y = pk2(acc[mt][nt][2], acc[mt][nt][3]);
                *(u32x2*)(stp + p * 128 + n) = w;
            }
    }
    __syncthreads();
}

__device__ __forceinline__ void gmlp_tile(const Args& a, LAS unsigned char* lds, int tile, int tid, int lane, int wave) {
    constexpr int VNT = 0;
    const int g = tile & 7, bc = tile >> 3; const size_t grow0 = (size_t)bc * 128;
    unsigned char* ws = a.ws; const bf16* GV = (const bf16*)(ws + WS_GV); const float* LNP = (const float*)(ws + WS_LNP); bf16* MIX = (bf16*)(ws + WS_MIX); const bf16* WGM = (const bf16*)(ws + WS_WGM);
    const float* ln_g = a.in[6]; const float* ln_b = a.in[7]; const float* b_s = a.in[9];
    {
        const int srow = tid >> 2, part = tid & 3; const size_t row = grow0 + srow;
        const f32x4 p0 = *(const f32x4*)(LNP + row * 32 + part * 8), p1 = *(const f32x4*)(LNP + row * 32 + part * 8 + 4);
        float s1 = (p0.x + p0.z) + (p1.x + p1.z), s2 = (p0.y + p0.w) + (p1.y + p1.w);
        s1 += __shfl_xor(s1, 1); s1 += __shfl_xor(s1, 2); s2 += __shfl_xor(s2, 1); s2 += __shfl_xor(s2, 2);
        const float mean = s1 * (1.f / 1024.f), var = s2 * (1.f / 1024.f) - mean * mean, rstd = rsqrtf(var + 1e-5f);
        if (part == 0) { f32x2 ms; ms.x = mean; ms.y = rstd; *(LAS f32x2*)(lds + 34816 + srow * 8) = ms; }
    }
    __syncthreads();
    {
        const int chg = tid & 15, s0 = (tid >> 4) * 4, ch = g * 128 + chg * 8;
        const f32x4 g0 = *(const f32x4*)(ln_g + ch), g1 = *(const f32x4*)(ln_g + ch + 4), c0 = *(const f32x4*)(ln_b + ch), c1 = *(const f32x4*)(ln_b + ch + 4);
        float val[4][8];
#pragma unroll
        for (int jj = 0; jj < 4; ++jj) {
            const u32x4 v = *(const u32x4*)(GV + (grow0 + s0 + jj) * 1024 + ch);
            const f32x2 ms = *(const LAS f32x2*)(lds + 34816 + (s0 + jj) * 8);
            const float mean = ms.x, rstd = ms.y;
            val[jj][0] = (bflo(v.x) - mean) * rstd * g0.x + c0.x; val[jj][1] = (bfhi(v.x) - mean) * rstd * g0.y + c0.y; val[jj][2] = (bflo(v.y) - mean) * rstd * g0.z + c0.z; val[jj][3] = (bfhi(v.y) - mean) * rstd * g0.w + c0.w;
            val[jj][4] = (bflo(v.z) - mean) * rstd * g1.x + c1.x; val[jj][5] = (bfhi(v.z) - mean) * rstd * g1.y + c1.y; val[jj][6] = (bflo(v.w) - mean) * rstd * g1.z + c1.z; val[jj][7] = (bfhi(v.w) - mean) * rstd * g1.w + c1.w;
        }
#pragma unroll
        for (int e = 0; e < 8; ++e) { u32x2 w; w.x = pk2(val[0][e], val[1][e]); w.y = pk2(val[2][e], val[3][e]); *(LAS u32x2*)(lds + VNT + ((chg * 8 + e) * 136 + s0) * 2) = w; }
    }
    __syncthreads();
    {
        const int wr = wave >> 1, wc = wave & 1, lr = lane & 15, q = lane >> 4;
        f32x4 acc[2][4];
#pragma unroll
        for (int mt = 0; mt < 2; ++mt)
#pragma unroll
            for (int nt = 0; nt < 4; ++nt) acc[mt][nt] = (f32x4){0.f, 0.f, 0.f, 0.f};
        for (int ks = 0; ks <= wr; ++ks) {
            bf16x8 af[2];
#pragma unroll
            for (int mt = 0; mt < 2; ++mt) af[mt] = *(const bf16x8*)(WGM + g * 16384 + (wr * 32 + mt * 16 + lr) * 128 + ks * 32 + q * 8);
#pragma unroll
            for (int nt = 0; nt < 4; ++nt) {
                const bf16x8 bfr = lds128(lds, VNT + ((wc * 64 + nt * 16 + lr) * 136 + ks * 32 + q * 8) * 2);
#pragma unroll
                for (int mt = 0; mt < 2; ++mt) acc[mt][nt] = mma(acc[mt][nt], af[mt], bfr);
            }
        }
#pragma unroll
        for (int mt = 0; mt < 2; ++mt) {
            const int t = wr * 32 + mt * 16 + lr; const float bias = b_s[g * 128 + t];
#pragma unroll
            for (int nt = 0; nt < 4; ++nt) {
                bf16* p = MIX + (grow0 + t) * 2048 + g * 128 + wc * 64 + nt * 16 + q * 4;
                const u32x2 uu = *(const u32x2*)p;
                u32x2 w; w.x = pk2((acc[mt][nt][0] + bias) * bflo(uu.x), (acc[mt][nt][1] + bias) * bfhi(uu.x)); w.y = pk2((acc[mt][nt][2] + bias) * bflo(uu.y), (acc[mt][nt][3] + bias) * bfhi(uu.y));
                *(u32x2*)p = w;
            }
        }
    }
    __syncthreads();
}

__device__ __forceinline__ void scan_phase(const Args& a, int tid, int G) {
    bf16* ST = (bf16*)(a.ws + WS_ST); const float* DEC = (const float*)(a.ws + WS_DEC);
    for (int idx = blockIdx.x * 512 + tid; idx < 131072; idx += G * 512) {
        const int pn8 = idx & 1023, h = (idx >> 10) & 15, b = idx >> 14;
        float st[8];
#pragma unroll
        for (int e = 0; e < 8; ++e) st[e] = 0.f;
#pragma unroll 1
        for (int c0 = 0; c0 < 32; c0 += 8) {
            u32x4 v[8]; float dec[8];
#pragma unroll
            for (int cc = 0; cc < 8; ++cc) { const size_t bch = ((size_t)(b * 32 + c0 + cc)) * 16 + h; v[cc] = *(const u32x4*)(ST + bch * 8192 + pn8 * 8); dec[cc] = DEC[bch]; }
#pragma unroll
            for (int cc = 0; cc < 8; ++cc) {
                const size_t bch = ((size_t)(b * 32 + c0 + cc)) * 16 + h;
                u32x4 w; w.x = pk2(st[0], st[1]); w.y = pk2(st[2], st[3]); w.z = pk2(st[4], st[5]); w.w = pk2(st[6], st[7]);
                *(u32x4*)(ST + bch * 8192 + pn8 * 8) = w;
                const float d = dec[cc];
                st[0] = d * st[0] + bflo(v[cc].x); st[1] = d * st[1] + bfhi(v[cc].x); st[2] = d * st[2] + bflo(v[cc].y); st[3] = d * st[3] + bfhi(v[cc].y);
                st[4] = d * st[4] + bflo(v[cc].z); st[5] = d * st[5] + bfhi(v[cc].z); st[6] = d * st[6] + bflo(v[cc].w); st[7] = d * st[7] + bfhi(v[cc].w);
            }
        }
    }
}

__device__ __forceinline__ void ssd_b_tile(const Args& a, LAS unsigned char* lds, int tile, int tid, int lane, int wave) {
    { int tz; asm volatile("v_mov_b32 %0, 0" : "=v"(tz)); tid += tz; lane += tz; }
    constexpr int XST = 0, CM = 69632, BM = 104448, ACUM = 139264, DTS = ACUM + 2048, PSS = DTS + 2048;
    const int g = tile & 3, bc = tile >> 2, c = bc & 31; const size_t grow0 = (size_t)bc * 128;
    unsigned char* ws = a.ws; const bf16* XBC = (const bf16*)(ws + WS_XBC); const float* DT = (const float*)(ws + WS_DT); const bf16* ST = (const bf16*)(ws + WS_ST); bf16* MIX = (bf16*)(ws + WS_MIX);
    const float* cw = a.in[10]; const float* cb = a.in[11]; const float* a_log = a.in[13]; const float* d_skip = a.in[14]; const float* norm_g = a.in[15];
    if (wave < 4) { float a0, a1, d0, d1; (void)ssd_scan(DT, a_log, grow0, g * 4 + wave, wave, lane, (LAS float*)(lds + ACUM), (LAS float*)(lds + DTS), a0, a1, d0, d1); }
    {
        const bool first = (c == 0);
        float o[8][8];
        {
            const int chg = tid & 31, l0 = (tid >> 5) * 8;
            conv8x8(XBC, grow0, l0, first, g * 256 + chg * 8, cw, cb, o);
#pragma unroll
            for (int e = 0; e < 8; ++e) {
                u32x4 w; w.x = pk2(o[0][e], o[1][e]); w.y = pk2(o[2][e], o[3][e]); w.z = pk2(o[4][e], o[5][e]); w.w = pk2(o[6][e], o[7][e]);
                *(LAS u32x4*)(lds + XST + ((chg * 8 + e) * 136 + l0) * 2) = w;
            }
        }
        {
            const int half = tid >> 8, chg = tid & 15, l0 = ((tid >> 4) & 15) * 8;
            conv8x8(XBC, grow0, l0, first, (half ? 1536 : 1024) + g * 128 + chg * 8, cw, cb, o);
            const int dstb = half ? CM : BM;
#pragma unroll
            for (int j = 0; j < 8; ++j) {
                u32x4 w; w.x = pk2(o[j][0], o[j][1]); w.y = pk2(o[j][2], o[j][3]); w.z = pk2(o[j][4], o[j][5]); w.w = pk2(o[j][6], o[j][7]);
                *(LAS u32x4*)(lds + dstb + ((l0 + j) * 136 + chg * 8) * 2) = w;
            }
        }
    }
    __syncthreads();
    const int lr = lane & 15, q = lane >> 4;
    const int r = wave >> 1, lh = wave & 1, h = g * 4 + r;
    bf16x8 pv[4][4];
    {
        const bf16* prev = ST + ((size_t)bc * 16 + h) * 8192;
#pragma unroll
        for (int ks = 0; ks < 4; ++ks)
#pragma unroll
            for (int nt = 0; nt < 4; ++nt) pv[ks][nt] = *(const bf16x8*)(prev + (nt * 16 + lr) * 128 + ks * 32 + q * 8);
    }
    u32x2 zpre[4][4]; f32x4 ngpre[4];
#pragma unroll
    for (int nt = 0; nt < 4; ++nt) { ngpre[nt] = *(const f32x4*)(norm_g + g * 256 + r * 64 + nt * 16 + q * 4);
#pragma unroll
        for (int mt = 0; mt < 4; ++mt) zpre[mt][nt] = *(const u32x2*)(MIX + (grow0 + lh * 64 + mt * 16 + lr) * 2048 + 1024 + g * 256 + r * 64 + nt * 16 + q * 4); }
    {
        const int wr4 = wave >> 1, wc2 = wave & 1;
        f32x4 cbv[2][4];
#pragma unroll
        for (int mt = 0; mt < 2; ++mt)
#pragma unroll
            for (int nt = 0; nt < 4; ++nt) cbv[mt][nt] = (f32x4){0.f, 0.f, 0.f, 0.f};
#pragma unroll
        for (int ks = 0; ks < 4; ++ks) {
            bf16x8 af[2];
#pragma unroll
            for (int mt = 0; mt < 2; ++mt) af[mt] = lds128(lds, CM + ((wr4 * 32 + mt * 16 + lr) * 136 + ks * 32 + q * 8) * 2);
#pragma unroll
            for (int nt = 0; nt < 4; ++nt) {
                const bf16x8 bfr = lds128(lds, BM + ((wc2 * 64 + nt * 16 + lr) * 136 + ks * 32 + q * 8) * 2);
#pragma unroll
                for (int mt = 0; mt < 2; ++mt) cbv[mt][nt] = mma(cbv[mt][nt], af[mt], bfr);
            }
        }
        __syncthreads();
#pragma unroll
        for (int mt = 0; mt < 2; ++mt)
#pragma unroll
            for (int nt = 0; nt < 4; ++nt) {
                u32x2 w; w.x = pk2(cbv[mt][nt][0], cbv[mt][nt][1]); w.y = pk2(cbv[mt][nt][2], cbv[mt][nt][3]);
                *(LAS u32x2*)(lds + BM + ((wr4 * 32 + mt * 16 + lr) * 136 + wc2 * 64 + nt * 16 + q * 4) * 2) = w;
            }
        __syncthreads();
    }
    const LAS float* acum = (const LAS float*)(lds + ACUM) + r * 128; const LAS float* dts = (const LAS float*)(lds + DTS) + r * 128;
    f32x4 acc[4][4];
#pragma unroll
    for (int mt = 0; mt < 4; ++mt)
#pragma unroll
        for (int nt = 0; nt < 4; ++nt) acc[mt][nt] = (f32x4){0.f, 0.f, 0.f, 0.f};
    {
#pragma unroll
        for (int ks = 0; ks < 4; ++ks) {
            bf16x8 af[4];
#pragma unroll
            for (int mt = 0; mt < 4; ++mt) af[mt] = lds128(lds, CM + ((lh * 64 + mt * 16 + lr) * 136 + ks * 32 + q * 8) * 2);
#pragma unroll
            for (int nt = 0; nt < 4; ++nt)
#pragma unroll
                for (int mt = 0; mt < 4; ++mt) acc[mt][nt] = mma(acc[mt][nt], af[mt], pv[ks][nt]);
        }
    }
    float al[4];
#pragma unroll
    for (int mt = 0; mt < 4; ++mt) { al[mt] = acum[lh * 64 + mt * 16 + lr]; const float sc = ex(al[mt]);
#pragma unroll
        for (int nt = 0; nt < 4; ++nt) acc[mt][nt] = acc[mt][nt] * sc; }
#pragma unroll 1
    for (int ks = 0; ks <= lh * 2 + 1; ++ks) {
        const int s0 = ks * 32 + q * 8;
        const f32x4 as0 = *(const LAS f32x4*)(acum + s0), as1 = *(const LAS f32x4*)(acum + s0 + 4), dd0 = *(const LAS f32x4*)(dts + s0), dd1 = *(const LAS f32x4*)(dts + s0 + 4);
        bf16x8 bx[4];
#pragma unroll
        for (int nt = 0; nt < 4; ++nt) bx[nt] = lds128(lds, XST + ((r * 64 + nt * 16 + lr) * 136 + s0) * 2);
#pragma unroll
        for (int mt = 0; mt < 4; ++mt) {
            if (lh * 64 + mt * 16 + 15 < ks * 32) continue;
            const int l = lh * 64 + mt * 16 + lr;
            const u32x4 raw = *(const LAS u32x4*)(lds + BM + (l * 136 + s0) * 2);
            float w[8];
            w[0] = bflo(raw.x); w[1] = bfhi(raw.x); w[2] = bflo(raw.y); w[3] = bfhi(raw.y); w[4] = bflo(raw.z); w[5] = bfhi(raw.z); w[6] = bflo(raw.w); w[7] = bfhi(raw.w);
#pragma unroll
            for (int e = 0; e < 8; ++e) {
                const float as = e < 4 ? as0[e & 3] : as1[e & 3], dd = e < 4 ? dd0[e & 3] : dd1[e & 3];
                const bool valid = (s0 + e) <= l;
                const float arg = valid ? (al[mt] - as) : 0.f;
                w[e] = valid ? w[e] * ex(arg) * dd : 0.f;
            }
            u32x4 pw; pw.x = pk2(w[0], w[1]); pw.y = pk2(w[2], w[3]); pw.z = pk2(w[4], w[5]); pw.w = pk2(w[6], w[7]);
            const bf16x8 af = __builtin_bit_cast(bf16x8, pw);
#pragma unroll
            for (int nt = 0; nt < 4; ++nt) acc[mt][nt] = mma(acc[mt][nt], af, bx[nt]);
        }
    }
    const float dsk = d_skip[h];
#pragma unroll
    for (int mt = 0; mt < 4; ++mt) {
        const int l = lh * 64 + mt * 16 + lr; float ssq = 0.f;
#pragma unroll
        for (int nt = 0; nt < 4; ++nt) {
            const int ch = r * 64 + nt * 16 + q * 4;
            const u32x2 zz = zpre[mt][nt];
            float xs[4], zf[4];
            zf[0] = bflo(zz.x); zf[1] = bfhi(zz.x); zf[2] = bflo(zz.y); zf[3] = bfhi(zz.y);
#pragma unroll
            for (int j = 0; j < 4; ++j) xs[j] = __uint_as_float(((unsigned)*(const LAS unsigned short*)(lds + XST + ((ch + j) * 136 + l) * 2)) << 16);
#pragma unroll
            for (int j = 0; j < 4; ++j) { const float y = (acc[mt][nt][j] + dsk * xs[j]) * silu(zf[j]); acc[mt][nt][j] = y; ssq += y * y; }
        }
        ssq += __shfl_xor(ssq, 16); ssq += __shfl_xor(ssq, 32);
        if (q == 0) ((LAS float*)(lds + PSS))[r * 128 + l] = ssq;
        __builtin_amdgcn_sched_barrier(0);
    }
    __syncthreads();
#pragma unroll
    for (int mt = 0; mt < 4; ++mt) {
        const int l = lh * 64 + mt * 16 + lr; const LAS float* pss = (const LAS float*)(lds + PSS);
        const float tot = (pss[l] + pss[128 + l]) + (pss[256 + l] + pss[384 + l]);
        const float rs = rsqrtf(tot * (1.f / 256.f) + 1e-5f);
#pragma unroll
        for (int nt = 0; nt < 4; ++nt) {
            const int ch = r * 64 + nt * 16 + q * 4;
            const f32x4 ng = ngpre[nt];
            u32x2 w; w.x = pk2(acc[mt][nt][0] * rs * ng.x, acc[mt][nt][1] * rs * ng.y); w.y = pk2(acc[mt][nt][2] * rs * ng.z, acc[mt][nt][3] * rs * ng.w);
            *(u32x2*)(MIX + (grow0 + l) * 2048 + 1024 + g * 256 + ch) = w;
        }
        __builtin_amdgcn_sched_barrier(0);
    }
    __syncthreads();
}

__device__ __forceinline__ void attn_tile(const Args& a, LAS unsigned char* lds, int tile, int tid, int lane, int wave) {
    constexpr int KB = 0, VT = 36864;
    const int kvh = tile & 1, bn = tile >> 1, nb = bn & 31;
    const bf16* QKV = (const bf16*)(a.ws + WS_QKV); bf16* ATT = (bf16*)(a.ws + WS_ATT); const float* sinks = a.in[20];
    if (tid < 256) {
        const int d0 = (tid & 7) * 8, s0 = (tid >> 3) * 8;
        u32x4 v[8];
#pragma unroll
        for (int j = 0; j < 8; ++j) { const int sk = s0 + j; v[j] = (u32x4){0u, 0u, 0u, 0u};
            if (nb > 0 || sk >= 128) v[j] = *(const u32x4*)(QKV + ((long)bn * 128 - 128 + sk) * QKVD + 1152 + kvh * 64 + d0); }
#pragma unroll
        for (int e = 0; e < 8; ++e) {
            unsigned hh[8];
#pragma unroll
            for (int j = 0; j < 8; ++j) { const unsigned wd = v[j][e >> 1]; hh[j] = (e & 1) ? (wd >> 16) : (wd & 0xffffu); }
            u32x4 w; w.x = hh[0] | (hh[1] << 16); w.y = hh[2] | (hh[3] << 16); w.z = hh[4] | (hh[5] << 16); w.w = hh[6] | (hh[7] << 16);
            *(LAS u32x4*)(lds + VT + ((d0 + e) * 264 + s0) * 2) = w;
        }
    } else {
        const int t2 = tid - 256;
#pragma unroll
        for (int i = 0; i < 8; ++i) {
            const int p = t2 + 256 * i, sk = p >> 3, pc = p & 7;
            u32x4 kv = {0u, 0u, 0u, 0u};
            if (nb > 0 || sk >= 128) kv = *(const u32x4*)(QKV + ((long)bn * 128 - 128 + sk) * QKVD + 1024 + kvh * 64 + pc * 8);
            *(LAS u32x4*)(lds + KB + (sk * 72 + pc * 8) * 2) = kv;
        }
    }
    __syncthreads();
    const int h = kvh * 8 + wave, lr = lane & 15, q4 = lane >> 4; const float sink = sinks[h];
    bf16x8 aqn[2];
#pragma unroll
    for (int ks = 0; ks < 2; ++ks) aqn[ks] = *(const bf16x8*)(QKV + ((size_t)bn * 128 + lr) * QKVD + h * 64 + ks * 32 + q4 * 8);
#pragma unroll 1
    for (int qc = 0; qc < 8; ++qc) {
        const int qi = qc * 16 + lr; const size_t qrow = (size_t)bn * 128 + qi;
        bf16x8 aq[2];
#pragma unroll
        for (int ks = 0; ks < 2; ++ks) aq[ks] = aqn[ks];
        { const size_t qnext = qrow + (qc < 7 ? 16 : 0);
#pragma unroll
          for (int ks = 0; ks < 2; ++ks) aqn[ks] = *(const bf16x8*)(QKV + qnext * QKVD + h * 64 + ks * 32 + q4 * 8); }
        f32x4 sc[10];
#pragma unroll
        for (int t = 0; t < 9; ++t) {
            sc[t] = (f32x4){0.f, 0.f, 0.f, 0.f};
#pragma unroll
            for (int ks = 0; ks < 2; ++ks) sc[t] = mma(sc[t], aq[ks], lds128(lds, KB + (((qc + t) * 16 + lr) * 72 + ks * 32 + q4 * 8) * 2));
        }
        sc[9] = (f32x4){0.f, 0.f, 0.f, 0.f};
        float m = sink;
#pragma unroll
        for (int t = 0; t < 9; ++t)
#pragma unroll
            for (int j = 0; j < 4; ++j) {
                const int si = (qc + t) * 16 + q4 * 4 + j;
                const bool valid = (si >= qi + 1) && (si <= qi + 128) && (nb > 0 || si >= 128);
                const float v = valid ? sc[t][j] * 0.125f : -INFINITY;
                sc[t][j] = v; m = fmaxf(m, v);
            }
        m = fmaxf(m, __shfl_xor(m, 16)); m = fmaxf(m, __shfl_xor(m, 32));
        float sum = 0.f;
#pragma unroll
        for (int t = 0; t < 9; ++t)
#pragma unroll
            for (int j = 0; j < 4; ++j) { const float p = ex(sc[t][j] - m); sc[t][j] = p; sum += p; }
        sum += __shfl_xor(sum, 16); sum += __shfl_xor(sum, 32);
        const float inv = 1.f / (sum + ex(sink - m));
        f32x4 o[4];
#pragma unroll
        for (int dt = 0; dt < 4; ++dt) o[dt] = (f32x4){0.f, 0.f, 0.f, 0.f};
#pragma unroll
        for (int kk = 0; kk < 5; ++kk) {
            const int t0 = 2 * kk, t1 = 2 * kk + 1;
            u32x4 pw; pw.x = pk2(sc[t0][0], sc[t0][1]); pw.y = pk2(sc[t0][2], sc[t0][3]); pw.z = pk2(sc[t1][0], sc[t1][1]); pw.w = pk2(sc[t1][2], sc[t1][3]);
            const bf16x8 af = __builtin_bit_cast(bf16x8, pw);
            const int T0 = qc + t0, T1 = (qc + t1) > 15 ? 15 : (qc + t1);
#pragma unroll
            for (int dt = 0; dt < 4; ++dt) {
                const u32x2 b0 = *(const LAS u32x2*)(lds + VT + ((dt * 16 + lr) * 264 + T0 * 16 + q4 * 4) * 2), b1 = *(const LAS u32x2*)(lds + VT + ((dt * 16 + lr) * 264 + T1 * 16 + q4 * 4) * 2);
                u32x4 bw; bw.x = b0.x; bw.y = b0.y; bw.z = b1.x; bw.w = b1.y;
                o[dt] = mma(o[dt], af, __builtin_bit_cast(bf16x8, bw));
            }
        }
#pragma unroll
        for (int dt = 0; dt < 4; ++dt) {
            u32x2 w; w.x = pk2(o[dt][0] * inv, o[dt][1] * inv); w.y = pk2(o[dt][2] * inv, o[dt][3] * inv);
            *(u32x2*)(ATT + qrow * 1024 + h * 64 + dt * 16 + q4 * 4) = w;
        }
    }
    __syncthreads();
}

__device__ __forceinline__ float wave_sum(float v) {
#pragma unroll
    for (int o = 1; o < 64; o <<= 1) v += __shfl_xor(v, o);
    return v;
}

#define XB_TMO      128
#define XB_XCNT(j)  (256  + 64 * (j))
#define XB_XSUB(j)  (1280 + 64 * (j))
#define XB_XGEN(j)  (2304 + 64 * (j))
#define XB_TOP      3328
#define XB_TOPGEN   3392
#define XCD_BAR_WORDS 3456
#define XB_SPIN_CAP (1u << 18)

__device__ __forceinline__ unsigned xb_ld(unsigned* p)              { return __hip_atomic_load(p, __ATOMIC_RELAXED, __HIP_MEMORY_SCOPE_AGENT); }
__device__ __forceinline__ unsigned xb_add(unsigned* p, unsigned v) { return __hip_atomic_fetch_add(p, v, __ATOMIC_RELAXED, __HIP_MEMORY_SCOPE_AGENT); }
__device__ __forceinline__ unsigned xb_xcc_id() { return (unsigned)__builtin_amdgcn_s_getreg((3 << 11) | 20) & 0xFu; }
#define XB_SPIN(cond, bar) do { unsigned _sp = 0; while (cond) { __builtin_amdgcn_s_sleep(1); \
    if ((++_sp & 255u) == 0u) { if (xb_ld(&(bar)[XB_TMO])) break; if (_sp > XB_SPIN_CAP) { atomicAdd(&(bar)[XB_TMO], 1u); break; } } } } while (0)

struct XcdBarrier {
    unsigned* bar; unsigned x;
    volatile LAS unsigned* st;
};

__device__ __forceinline__ XcdBarrier xcd_barrier_post(unsigned* bar, volatile LAS unsigned* st) {
    XcdBarrier b; b.bar = bar; b.x = xb_xcc_id(); b.st = st;
    if (threadIdx.x == 0) (void)xb_add(&bar[XB_XCNT(b.x)], 1u);
    return b;
}
__device__ __forceinline__ void xcd_barrier_complete(unsigned* bar, unsigned x, unsigned& nloc, unsigned& nx) {
    const unsigned G = gridDim.x * gridDim.y * gridDim.z;
    unsigned sum, cnt, mine, sp = 0u;
    for (;;) {
        sum = 0u; cnt = 0u; mine = 0u;
#pragma unroll
        for (unsigned j = 0; j < 16; ++j) { const unsigned c = xb_ld(&bar[XB_XCNT(j)]); sum += c; cnt += (c > 0u) ? 1u : 0u; mine = (j == x) ? c : mine; }
        if (sum == G) break;
        __builtin_amdgcn_s_sleep(1);
        if ((++sp & 255u) == 0u) { if (xb_ld(&bar[XB_TMO])) break; if (sp > XB_SPIN_CAP) { atomicAdd(&bar[XB_TMO], 1u); break; } }
    }
    nloc = mine > 0u ? mine : 1u; nx = cnt > 0u ? cnt : 1u;
}

__device__ __forceinline__ void xcd_barrier(const XcdBarrier& b) {
    asm volatile("s_waitcnt vmcnt(0)" ::: "memory");
    __syncthreads();
    if (threadIdx.x == 0) {
        unsigned* bar = b.bar;
        __builtin_amdgcn_s_waitcnt(0);
        unsigned nloc = b.st[0], nx = b.st[1];
        if (nloc == 0u) { xcd_barrier_complete(bar, b.x, nloc, nx); b.st[0] = nloc; b.st[1] = nx; }
        const unsigned old = xb_add(&bar[XB_XSUB(b.x)], 1u);
        const unsigned gen = old / nloc;
        if (old + 1u == (gen + 1u) * nloc) {
            __builtin_amdgcn_fence(__ATOMIC_RELEASE, "agent");
            asm volatile("s_waitcnt vmcnt(0)" ::: "memory");
            const unsigned og = xb_add(&bar[XB_TOP], 1u);
            const unsigned tg = og / nx;
            if (og + 1u == (tg + 1u) * nx) xb_add(&bar[XB_TOPGEN], 1u);
            else XB_SPIN(xb_ld(&bar[XB_TOPGEN]) == tg, bar);
            __builtin_amdgcn_fence(__ATOMIC_ACQUIRE, "agent");
            xb_add(&bar[XB_XGEN(b.x)], 1u);
            asm volatile("s_waitcnt vmcnt(0)" ::: "memory");
        } else {
            XB_SPIN(xb_ld(&bar[XB_XGEN(b.x)]) == gen, bar);
            __builtin_amdgcn_fence(__ATOMIC_ACQUIRE, "agent");
            asm volatile("s_waitcnt vmcnt(0)" ::: "memory");
        }
    }
    __syncthreads();
}

__global__ void __launch_bounds__(512, 2) hybrid_fwd(Args args) {
    extern __shared__ __attribute__((aligned(16))) unsigned char lds_raw[];
    LAS unsigned char* lds = (LAS unsigned char*)lds_raw;
    const int tid = threadIdx.x, lane = tid & 63, wave = __builtin_amdgcn_readfirstlane(tid >> 6), G = gridDim.x;
    unsigned char* ws = args.ws;
    const int lo = args.ph_lo, hi = args.ph_hi;
    cg::grid_group grid = cg::this_grid();
    if (lo > hi) grid.sync();
    volatile LAS unsigned* bst = (volatile LAS unsigned*)(lds + LDS_BYTES - 16);
    if (tid < 4) bst[tid] = 0u;
    __syncthreads();
    XcdBarrier bar = xcd_barrier_post((unsigned*)ws, bst);
#ifndef PH_MASK
#define PH_MASK 0x3fff
#endif
#define IN(k) (((PH_MASK >> (k)) & 1) && lo <= (k) && (k) < hi)
#define SEAM(k) do { if (IN(k) && IN((k) + 1)) { xcd_barrier(bar); } } while (0)
    bf16* XB = (bf16*)(ws + WS_XB); float* SSP = (float*)(ws + WS_SSP); float* H = args.out;

    if (IN(0)) { phase0(args, lds, tid, lane, wave, G); } SEAM(0);
    if (IN(1)) {
        pg8::Gemm g{XB, (const bf16*)(ws + WS_WIN), MTOK, NPROJ, DM}; pg8::StaticOrder S; S.init(MTOK, NPROJ, G, (int)blockIdx.x);
        EpiInProj E{SSP, (bf16*)(ws + WS_MIX), (bf16*)(ws + WS_GV), (bf16*)(ws + WS_XBC), (float*)(ws + WS_LNP)};
        pg8::gemm_phase<EpiInProj, pg8::StaticOrder, true, true>(lds, g, S, E);
    } SEAM(1);
    if (IN(2)) {
        for (int t = blockIdx.x; t < 1024 + 2048; t += G) { if (t < 1024) ssd_a_tile(args, lds, t, tid, lane, wave); else gmlp_tile(args, lds, t - 1024, tid, lane, wave); }
    } SEAM(2);
    if (IN(3)) { scan_phase(args, tid, G); } SEAM(3);
    if (IN(4)) { for (int t = blockIdx.x; t < 1024; t += G) ssd_b_tile(args, lds, t, tid, lane, wave); } SEAM(4);
    if (IN(5)) {
        pg8::Gemm g{(const bf16*)(ws + WS_MIX), (const bf16*)(ws + WS_WOUT), MTOK, DM, 2048}; pg8::StaticOrder S; S.init(MTOK, DM, G, (int)blockIdx.x);
        EpiResid E{XB, SSP, nullptr};
        pg8::gemm_phase<EpiResid, pg8::StaticOrder, true, true>(lds, g, S, E);
    } SEAM(5);
    if (IN(6)) {
        pg8::Gemm g{XB, (const bf16*)(ws + WS_WUP0), MTOK, DFF, DM}; pg8::StaticOrder S; S.init(MTOK, DFF, G, (int)blockIdx.x);
        EpiRelu2 E{SSP, (bf16*)(ws + WS_HID)};
        pg8::gemm_phase<EpiRelu2, pg8::StaticOrder, true, true>(lds, g, S, E);
    } SEAM(6);
    if (IN(7)) {
        pg8::Gemm g{(const bf16*)(ws + WS_HID), (const bf16*)(ws + WS_WDN0), MTOK, DM, DFF}; pg8::StaticOrder S; S.init(MTOK, DM, G, (int)blockIdx.x);
        EpiResid E{XB, SSP, nullptr};
        pg8::gemm_phase<EpiResid, pg8::StaticOrder, true, true>(lds, g, S, E);
    } SEAM(7);
    if (IN(8)) {
        pg8::Gemm g{XB, (const bf16*)(ws + WS_WQKV), MTOK, QKVD, DM}; pg8::StaticOrder S; S.init(MTOK, QKVD, G, (int)blockIdx.x);
        EpiQKV E{SSP, (bf16*)(ws + WS_QKV), args.in[17]};
        pg8::gemm_phase<EpiQKV, pg8::StaticOrder, true, true>(lds, g, S, E);
    } SEAM(8);
    if (IN(9)) { for (int t = blockIdx.x; t < 512; t += G) attn_tile(args, lds, t, tid, lane, wave); } SEAM(9);
    if (IN(10)) {
        pg8::Gemm g{(const bf16*)(ws + WS_ATT), (const bf16*)(ws + WS_WO), MTOK, DM, DM}; pg8::StaticOrder S; S.init(MTOK, DM, G, (int)blockIdx.x);
        EpiResid E{XB, SSP, args.in[19]};
        pg8::gemm_phase<EpiResid, pg8::StaticOrder, true, true>(lds, g, S, E);
    } SEAM(10);
    if (IN(11)) {
        pg8::Gemm g{XB, (const bf16*)(ws + WS_WUP1), MTOK, DFF, DM}; pg8::StaticOrder S; S.init(MTOK, DFF, G, (int)blockIdx.x);
        EpiRelu2 E{SSP, (bf16*)(ws + WS_HID)};
        pg8::gemm_phase<EpiRelu2, pg8::StaticOrder, true, true>(lds, g, S, E);
    } SEAM(11);
    if (IN(12)) {
        pg8::Gemm g{(const bf16*)(ws + WS_HID), (const bf16*)(ws + WS_WDN1), MTOK, DM, DFF}; pg8::StaticOrder S; S.init(MTOK, DM, G, (int)blockIdx.x);
        EpiResid E{XB, SSP, nullptr};
        pg8::gemm_phase<EpiResid, pg8::StaticOrder, true, true>(lds, g, S, E);
    } SEAM(12);
    if (IN(13)) {
        const float* fg = args.in[3];
        f32x4 gv[2][2];
#pragma unroll
        for (int j = 0; j < 2; ++j) { gv[j][0] = *(const f32x4*)(fg + j * 512 + lane * 8); gv[j][1] = *(const f32x4*)(fg + j * 512 + lane * 8 + 4); }
        for (int m = blockIdx.x * 8 + wave; m < MTOK; m += G * 8) {
            f32x4 v[2][2]; float sq = 0.f;
#pragma unroll
            for (int j = 0; j < 2; ++j) { const u32x4 r = *(const u32x4*)(XB + (size_t)m * DM + j * 512 + lane * 8);
                v[j][0] = (f32x4){bflo(r.x), bfhi(r.x), bflo(r.y), bfhi(r.y)}; v[j][1] = (f32x4){bflo(r.z), bfhi(r.z), bflo(r.w), bfhi(r.w)};
#pragma unroll
                for (int k = 0; k < 2; ++k) sq += (v[j][k].x * v[j][k].x + v[j][k].y * v[j][k].y) + (v[j][k].z * v[j][k].z + v[j][k].w * v[j][k].w); }
            const float rs = rsqrtf(wave_sum(sq) * (1.f / 1024.f) + 1e-5f);
#pragma unroll
            for (int j = 0; j < 2; ++j)
#pragma unroll
                for (int k = 0; k < 2; ++k) *(f32x4*)(H + (size_t)m * DM + j * 512 + lane * 8 + k * 4) = v[j][k] * rs * gv[j][k];
        }
    }
#ifdef DBG_STOP
    if (lo == 100) {
        const unsigned short* base = (const unsigned short*)(ws + (size_t)DBG_LO * MiB); const size_t n = (size_t)(DBG_HI - DBG_LO) * MiB / 2;
        for (size_t i = (size_t)blockIdx.x * 512 + tid; i < (size_t)MTOK * DM; i += (size_t)G * 512) { float sum = 0.f; for (size_t e = i; e < n; e += (size_t)MTOK * DM) sum += (float)base[e]; args.out[i] = sum; }
    }
#endif
#undef IN
#undef SEAM
}

#ifndef MK_N_LAUNCHES
#define MK_N_LAUNCHES 14
#endif

__global__ void dbg_fill(float* o, size_t n, float v) { for (size_t i = (size_t)blockIdx.x * 256 + threadIdx.x; i < n; i += (size_t)gridDim.x * 256) o[i] = v; }
extern "C" void kernel_launch(void* const* d_in, const int* in_sizes, int n_in, void* d_out, int out_size, void* d_ws, size_t ws_size, hipStream_t stream) {
    static int grid = 0;
    if (grid == 0) {
        if (n_in != 23 || in_sizes[0] != MTOK * DM || out_size != MTOK * DM || ws_size < WS_END) {
            fprintf(stderr, "kernel_launch: unexpected shapes: n_in %d in0 %d out %d ws %zu (need %zu)\n", n_in, n_in > 0 ? in_sizes[0] : -1, out_size, ws_size, (size_t)WS_END); grid = -1; return; }
        int dev = 0, cus = 0, per_cu = 0;
        if (hipGetDevice(&dev) != hipSuccess || hipDeviceGetAttribute(&cus, hipDeviceAttributeMultiprocessorCount, dev) != hipSuccess) { fprintf(stderr, "kernel_launch: device query failed\n"); grid = -1; return; }
        if (hipFuncSetAttribute((const void*)hybrid_fwd, hipFuncAttributeMaxDynamicSharedMemorySize, LDS_BYTES) != hipSuccess) { fprintf(stderr, "kernel_launch: hipFuncSetAttribute failed\n"); grid = -1; return; }
        if (hipOccupancyMaxActiveBlocksPerMultiprocessor(&per_cu, (const void*)hybrid_fwd, 512, LDS_BYTES) != hipSuccess || per_cu < 1) { fprintf(stderr, "kernel_launch: occupancy query says %d\n", per_cu); per_cu = 1; }
        (void)hipGetLastError();
        grid = cus * per_cu;
    }
    if (grid < 0) return;
    if (hipMemsetAsync(d_ws, 0, 16384, stream) != hipSuccess) { fprintf(stderr, "kernel_launch: memset failed\n"); return; }
    Args a{};
    for (int i = 0; i < 23; ++i) a.in[i] = (const float*)d_in[i];
    a.out = (float*)d_out; a.ws = (unsigned char*)d_ws;
#if MK_N_LAUNCHES == 1
    a.ph_lo = 0; a.ph_hi = NPHASE;
    void* kargs[] = {&a};
    hipError_t e = hipLaunchCooperativeKernel((const void*)hybrid_fwd, dim3(grid), dim3(512), kargs, LDS_BYTES, stream);
    if (e != hipSuccess) fprintf(stderr, "kernel_launch: cooperative launch failed: %s (grid %d)\n", hipGetErrorString(e), grid);
#else
#ifdef DBG_STOP
    for (int p = 0; p <= DBG_STOP; ++p) { a.ph_lo = p; a.ph_hi = p + 1; hipLaunchKernelGGL(hybrid_fwd, dim3(grid), dim3(512), LDS_BYTES, stream, a); }
    if (DBG_HI > DBG_LO) { a.ph_lo = 100; a.ph_hi = 101; hipLaunchKernelGGL(hybrid_fwd, dim3(grid), dim3(512), LDS_BYTES, stream, a); }
#else
    for (int p = 0; p < NPHASE; ++p) { a.ph_lo = p; a.ph_hi = p + 1; hipLaunchKernelGGL(hybrid_fwd, dim3(grid), dim3(512), LDS_BYTES, stream, a); }
#endif
#endif
}
```

```cpp
#define MK_N_LAUNCHES 1
#include <hip/hip_runtime.h>
#include <hip/hip_cooperative_groups.h>
#include <cstdio>
#include <cstdint>
namespace cg = cooperative_groups;
namespace pg8 {
#define PG8_LAS __attribute__((address_space(3)))
typedef unsigned short bf16_t;
typedef short bf16x8 __attribute__((ext_vector_type(8)));
typedef float f32x4 __attribute__((ext_vector_type(4)));
typedef unsigned u32x4 __attribute__((ext_vector_type(4)));
constexpr int BM = 256, BK = 64, HALF = 128, HTB = HALF * BK * 2  , STAGE_BYTES = 8 * HTB, NXCD = 8, WGM = 8;

__host__ __device__ __forceinline__ int lds_byte(int r, int c) { const int st = (r >> 4) * 2 + (c >> 5), rr = r & 15, cc = c & 31, ob = rr * 64 + cc * 2; return st * 1024 + (ob ^ (((ob >> 9) & 1) << 5)); }
__host__ __device__ __forceinline__ void stage_rc(int b, int& R, int& C) { const int st = b / 1024, sb = b % 1024, swz = sb ^ (((sb >> 9) & 1) << 5); R = (st >> 1) * 16 + swz / 64; C = (st & 1) * 32 + (swz % 64) / 2; }
__host__ __device__ __forceinline__ int perm32(int rho) { const int n = rho >> 4, i = rho & 15; return 8 * (i >> 2) + 4 * n + (i & 3); }

struct Unit { int pm, pn; };
struct Gemm { const bf16_t* A; const bf16_t* Bt; int M, N, K; int lda; };

struct StaticOrder {
    int nM, nN, nwg, G, c;
    __host__ __device__ void init(int M, int N, int G_, int c_) { nM = M / BM; nN = N / BM; nwg = nM * nN; G = G_; c = c_; }
    __host__ __device__ bool next(int i, Unit& u) const {
        const long L = (long)i * G + c; if (L >= nwg) return false;
        int wgid = (int)L; { const int q = nwg / NXCD, r = nwg % NXCD, xcd = wgid % NXCD, off = wgid / NXCD; wgid = (xcd < r ? xcd * (q + 1) : r * (q + 1) + (xcd - r) * q) + off; }
        const int nig = WGM * nN, gid = wgid / nig, fm = gid * WGM, gsz = (nM - fm) < WGM ? (nM - fm) : WGM;
        u.pm = fm + ((wgid % nig) % gsz); u.pn = (wgid % nig) / gsz; return true;
    }
    __device__ __forceinline__ void a_ready(const Unit&) const {}
    __device__ __forceinline__ void done(const Unit&) const {}
};

__device__ __forceinline__ unsigned cvt_pk_bf16(float lo, float hi) { unsigned r; asm volatile("v_cvt_pk_bf16_f32 %0, %1, %2" : "=v"(r) : "v"(lo), "v"(hi)); return r; }
typedef float f32x2 __attribute__((ext_vector_type(2)));
template <class Epi, class Sched, bool ALIGN_EPI = false, bool SP2 = false>
__device__ __forceinline__ void gemm_phase(PG8_LAS unsigned char* lds, const Gemm g, const Sched& S, const Epi& E) {
    const int tid = threadIdx.x, wid = __builtin_amdgcn_readfirstlane(tid >> 6), lane = tid & 63, wr = wid >> 2, wc = wid & 3, fr = lane & 15, fq = lane >> 4;
    const int K = g.K, nt = K / BK, lda = g.lda ? g.lda : g.K;
    unsigned voffA[2], voffB[2];
#pragma unroll
    for (int i = 0; i < 2; ++i) { int R, C; stage_rc(tid * 16 + i * 8192, R, C); const int Rb = Epi::PERM ? ((R & ~31) + perm32(R & 31)) : R;
        voffA[i] = (unsigned)(R * lda + C) * 2u; voffB[i] = (unsigned)(Rb * K + C) * 2u; }
    const size_t kstep = (size_t)(BK * 2);
    const size_t hstep = (size_t)HALF * K * 2;
    const size_t tstep = 2 * hstep; const size_t hstepA = (size_t)HALF * lda * 2, tstepA = 2 * hstepA;
    const unsigned ldsw = (unsigned)wid * 1024u;
    const int aoff = lds_byte(wr * 64 + fr, fq * 8), boff = lds_byte(wc * 32 + fr, fq * 8);
#define PG8_SA(b, h) (((b) * 2 + (h)) * HTB)
#define PG8_SB(b, h) ((4 + (b) * 2 + (h)) * HTB)
#define PG8_STAGE(bufoff, gbase, voff) do { _Pragma("unroll") for (int _i = 0; _i < 2; ++_i) \
        __builtin_amdgcn_global_load_lds((const unsigned*)((const char*)(gbase) + (voff)[_i]), (PG8_LAS unsigned*)(lds + (bufoff) + ldsw + _i * 8192), 16, 0, 0); } while (0)
#define PG8_LDA(dst, b, h) do { _Pragma("unroll") for (int m = 0; m < 4; ++m) _Pragma("unroll") for (int k = 0; k < 2; ++k) dst[m][k] = *(const PG8_LAS bf16x8*)(lds + PG8_SA(b, h) + aoff + m * 2048 + k * 1024); } while (0)
#define PG8_LDB(dst, b, h) do { _Pragma("unroll") for (int n = 0; n < 2; ++n) _Pragma("unroll") for (int k = 0; k < 2; ++k) dst[n][k] = *(const PG8_LAS bf16x8*)(lds + PG8_SB(b, h) + boff + n * 2048 + k * 1024); } while (0)
#define PG8_MMA(ai, bj, At, Bt) do { __builtin_amdgcn_s_setprio(1); _Pragma("unroll") for (int m = 0; m < 4; ++m) _Pragma("unroll") for (int n = 0; n < 2; ++n) _Pragma("unroll") for (int k = 0; k < 2; ++k) \
        acc[ai][bj][m][n] = __builtin_amdgcn_mfma_f32_16x16x32_bf16(Bt[n][k], At[m][k], acc[ai][bj][m][n], 0, 0, 0); __builtin_amdgcn_s_setprio(0); } while (0)
#define PG8_WAIT_V(n) asm volatile("s_waitcnt vmcnt(" #n ")" ::: "memory")
#define PG8_WAIT_L(n) asm volatile("s_waitcnt lgkmcnt(" #n ")" ::: "memory")
#define PG8_BAR __builtin_amdgcn_s_barrier()
#define PG8_SCHED __builtin_amdgcn_sched_barrier(0)
    Unit cur, nxt; int ui = 0;
    if (!S.next(0, cur)) return;
    f32x4 acc[2][2][4][2];
#pragma unroll
    for (int a = 0; a < 2; ++a)
#pragma unroll
        for (int b = 0; b < 2; ++b)
#pragma unroll
            for (int m = 0; m < 4; ++m)
#pragma unroll
                for (int n = 0; n < 2; ++n) acc[a][b][m][n] = (f32x4){0.f, 0.f, 0.f, 0.f};
    bf16x8 At[4][2], B0[2][2], B1[2][2];
    const char* cA = (const char*)g.A + (size_t)cur.pm * tstepA; const char* cB = (const char*)g.Bt + (size_t)cur.pn * tstep;
    S.a_ready(cur);
    if constexpr (SP2) {
        PG8_STAGE(PG8_SB(0, 0), cB, voffB); PG8_STAGE(PG8_SB(0, 1), cB + hstep, voffB); PG8_STAGE(PG8_SA(0, 0), cA, voffA); PG8_STAGE(PG8_SA(0, 1), cA + hstepA, voffA);
        if (wr == 1) PG8_BAR;
        PG8_WAIT_V(2); PG8_BAR;
        PG8_STAGE(PG8_SB(1, 0), cB + kstep, voffB); PG8_STAGE(PG8_SA(1, 0), cA + kstep, voffA); PG8_STAGE(PG8_SB(1, 1), cB + hstep + kstep, voffB);
        PG8_WAIT_V(6); PG8_BAR;
    } else {
        PG8_STAGE(PG8_SB(0, 0), cB, voffB); PG8_STAGE(PG8_SA(0, 0), cA, voffA); PG8_STAGE(PG8_SB(0, 1), cB + hstep, voffB); PG8_STAGE(PG8_SA(0, 1), cA + hstepA, voffA);
        if (wr == 1) PG8_BAR;
        PG8_WAIT_V(4); PG8_BAR;
        PG8_STAGE(PG8_SB(1, 0), cB + kstep, voffB); PG8_STAGE(PG8_SA(1, 0), cA + kstep, voffA); PG8_STAGE(PG8_SB(1, 1), cB + hstep + kstep, voffB);
        PG8_WAIT_V(6); PG8_BAR;
    }
    for (;;) {
        const bool has_next = S.next(ui + 1, nxt);
        const char* nA = has_next ? (const char*)g.A + (size_t)nxt.pm * tstepA : cA; const char* nB = has_next ? (const char*)g.Bt + (size_t)nxt.pn * tstep : cB;
        for (int t = 0; t < nt; t += 2) {
            const bool last = (t == nt - 2);
            const char* a1 = cA + (size_t)(t + 1) * kstep;
            const char* a2 = last ? nA : cA + (size_t)(t + 2) * kstep; const char* b2 = last ? nB : cB + (size_t)(t + 2) * kstep;
            const char* a3 = a2 + kstep; const char* b3 = b2 + kstep;
            if (last && has_next) S.a_ready(nxt);
            if constexpr (SP2) {
            PG8_LDB(B0, 0, 0); PG8_LDB(B1, 0, 1); PG8_SCHED; PG8_LDA(At, 0, 0); PG8_STAGE(PG8_SA(1, 1), a1 + hstepA, voffA);
            PG8_WAIT_V(8); PG8_WAIT_L(0); PG8_BAR; PG8_MMA(0, 0, At, B0); PG8_MMA(0, 1, At, B1); PG8_BAR; PG8_SCHED;
            PG8_LDA(At, 0, 1); PG8_STAGE(PG8_SB(0, 0), b2, voffB); PG8_STAGE(PG8_SB(0, 1), b2 + hstep, voffB); PG8_STAGE(PG8_SA(0, 0), a2, voffA);
            PG8_WAIT_V(8); PG8_WAIT_L(0); PG8_BAR; PG8_MMA(1, 0, At, B0); PG8_MMA(1, 1, At, B1); PG8_BAR; PG8_SCHED;
            PG8_LDB(B0, 1, 0); PG8_LDB(B1, 1, 1); PG8_SCHED; PG8_LDA(At, 1, 0); PG8_STAGE(PG8_SA(0, 1), a2 + hstepA, voffA);
            PG8_WAIT_V(8); PG8_WAIT_L(0); PG8_BAR; PG8_MMA(0, 0, At, B0); PG8_MMA(0, 1, At, B1); PG8_BAR; PG8_SCHED;
            PG8_LDA(At, 1, 1); PG8_STAGE(PG8_SB(1, 0), b3, voffB); PG8_STAGE(PG8_SB(1, 1), b3 + hstep, voffB); PG8_STAGE(PG8_SA(1, 0), a3, voffA);
            PG8_WAIT_V(8); PG8_WAIT_L(0); PG8_BAR; PG8_MMA(1, 0, At, B0); PG8_MMA(1, 1, At, B1); PG8_BAR; PG8_SCHED;
            } else {
            PG8_LDB(B0, 0, 0); PG8_SCHED; PG8_LDA(At, 0, 0); PG8_STAGE(PG8_SA(1, 1), a1 + hstepA, voffA);
            PG8_WAIT_L(8); PG8_BAR; PG8_WAIT_L(0); PG8_MMA(0, 0, At, B0); PG8_BAR; PG8_SCHED;
            PG8_LDB(B1, 0, 1); PG8_STAGE(PG8_SB(0, 0), b2, voffB);
            PG8_BAR; PG8_WAIT_L(0); PG8_MMA(0, 1, At, B1); PG8_BAR;
            PG8_LDA(At, 0, 1); PG8_STAGE(PG8_SA(0, 0), a2, voffA);
            PG8_BAR; PG8_WAIT_L(0); PG8_MMA(1, 0, At, B0); PG8_BAR; PG8_SCHED;
            PG8_STAGE(PG8_SB(0, 1), b2 + hstep, voffB);
            PG8_WAIT_V(6); PG8_BAR; PG8_MMA(1, 1, At, B1); PG8_BAR;
            PG8_LDB(B0, 1, 0); PG8_SCHED; PG8_LDA(At, 1, 0); PG8_STAGE(PG8_SA(0, 1), a2 + hstepA, voffA);
            PG8_WAIT_L(8); PG8_BAR; PG8_WAIT_L(0); PG8_MMA(0, 0, At, B0); PG8_BAR; PG8_SCHED;
            PG8_LDB(B1, 1, 1); PG8_STAGE(PG8_SB(1, 0), b3, voffB);
            PG8_BAR; PG8_WAIT_L(0); PG8_MMA(0, 1, At, B1); PG8_BAR;
            PG8_LDA(At, 1, 1); PG8_STAGE(PG8_SA(1, 0), a3, voffA);
            PG8_BAR; PG8_WAIT_L(0); PG8_MMA(1, 0, At, B0); PG8_BAR; PG8_SCHED;
            PG8_STAGE(PG8_SB(1, 1), b3 + hstep, voffB);
            PG8_WAIT_V(6); PG8_BAR; PG8_MMA(1, 1, At, B1); PG8_BAR;
            }
        }
        if constexpr (ALIGN_EPI) { if (wr == 0) PG8_BAR; }
        if constexpr (!Epi::AFTER_DRAIN) { E(acc, cur, wr, wc, fr, fq); S.done(cur); }
        if (!has_next) break;
#pragma unroll
        for (int a = 0; a < 2; ++a)
#pragma unroll
            for (int b = 0; b < 2; ++b)
#pragma unroll
                for (int m = 0; m < 4; ++m)
#pragma unroll
                    for (int n = 0; n < 2; ++n) acc[a][b][m][n] = (f32x4){0.f, 0.f, 0.f, 0.f};
        cur = nxt; cA = nA; cB = nB; ++ui;
        if constexpr (ALIGN_EPI) { if (wr == 1) PG8_BAR; }
    }
    PG8_WAIT_V(0);
    if constexpr (!ALIGN_EPI) { if (wr == 0) PG8_BAR; }
    PG8_BAR;
    if constexpr (Epi::AFTER_DRAIN) { E.fused(acc, cur, wr, wc, fr, fq, lds, wid, lane); S.done(cur); }
#undef PG8_SA
#undef PG8_SB
#undef PG8_STAGE
#undef PG8_LDA
#undef PG8_LDB
#undef PG8_MMA
#undef PG8_WAIT_V
#undef PG8_WAIT_L
#undef PG8_BAR
#undef PG8_SCHED
}
}

#define LAS __attribute__((address_space(3)))
typedef unsigned short bf16;
typedef unsigned u32x4 __attribute__((ext_vector_type(4)));
typedef unsigned u32x2 __attribute__((ext_vector_type(2)));
typedef float f32x4 __attribute__((ext_vector_type(4)));
typedef float f32x2 __attribute__((ext_vector_type(2)));
typedef short bf16x8 __attribute__((ext_vector_type(8)));
#define LDS_WAIT() asm volatile("s_waitcnt lgkmcnt(0)" ::: "memory")

constexpr int MTOK = 32768, DM = 1024, DFF = 4096, QKVD = 1280, INEV = 5136, NPROJ = 5120;
constexpr size_t MiB = 1u << 20;
constexpr size_t WS_WGM = 1 * MiB, WS_WIN = 2 * MiB, WS_WOUT = 12 * MiB, WS_WUP0 = 16 * MiB, WS_WUP1 = 24 * MiB, WS_WDN0 = 32 * MiB, WS_WDN1 = 40 * MiB,
                 WS_WQKV = 48 * MiB, WS_WO = 51 * MiB, WS_DT = 53 * MiB, WS_SSP = 55 * MiB, WS_LNP = 57 * MiB, WS_DEC = 61 * MiB, WS_XB = 62 * MiB, WS_ST = 126 * MiB,
                 WS_MIX = 190 * MiB, WS_GV = 318 * MiB, WS_XBC = 382 * MiB, WS_HID = 190 * MiB, WS_QKV = 190 * MiB, WS_ATT = 270 * MiB, WS_END = 510 * MiB;
constexpr int LDS_BYTES = 147456;
constexpr int HIDP = DFF + 64;
constexpr int NPHASE = 14;

typedef __bf16 bf16x2_t __attribute__((ext_vector_type(2)));
__device__ __forceinline__ unsigned pk2(float lo, float hi) { const f32x2 v = {lo, hi}; const bf16x2_t b = __builtin_convertvector(v, bf16x2_t); return __builtin_bit_cast(unsigned, b); }
__device__ __forceinline__ float bflo(unsigned u) { return __uint_as_float(u << 16); }
__device__ __forceinline__ float bfhi(unsigned u) { return __uint_as_float(u & 0xffff0000u); }
__device__ __forceinline__ float ex(float x) { return __builtin_amdgcn_exp2f(x * 1.4426950408889634f); }
__device__ __forceinline__ float rcp(float x) { return __builtin_amdgcn_rcpf(x); }
__device__ __forceinline__ float gelu_t(float x) { const float u = 1.5957691216057308f * (x + 0.044715f * x * x * x); return x * rcp(1.f + ex(-u)); }
__device__ __forceinline__ float silu(float x) { return x * rcp(1.f + ex(-x)); }
__device__ __forceinline__ f32x4 mma(f32x4 acc, bf16x8 a, bf16x8 b) { return __builtin_amdgcn_mfma_f32_16x16x32_bf16(b, a, acc, 0, 0, 0); }
__device__ __forceinline__ bf16x8 lds128(LAS unsigned char* lds, int byteoff) { return *(const LAS bf16x8*)(lds + byteoff); }
__device__ __forceinline__ void st16(LAS unsigned char* lds, int byteoff, unsigned v) { *(LAS unsigned short*)(lds + byteoff) = (unsigned short)v; }

struct Args { const float* in[23]; float* out; unsigned char* ws; int ph_lo, ph_hi; };

__device__ __forceinline__ float row_rstd(const float* ssp, size_t row, int fq) {
    const f32x4 p = *(const f32x4*)(ssp + row * 16 + fq * 4);
    float s = (p.x + p.y) + (p.z + p.w);
    s += __shfl_xor(s, 16); s += __shfl_xor(s, 32);
    return rsqrtf(s * (1.f / 1024.f) + 1e-5f);
}
struct EpiInProj {
    static constexpr bool PERM = true, AFTER_DRAIN = false;
    const float* ssp; bf16* mix; bf16* gv; bf16* xbc; float* lnp;
    __device__ __forceinline__ void operator()(const f32x4 (&acc)[2][2][4][2], const pg8::Unit& u, int wr, int wc, int fr, int fq) const {
        const size_t row0 = (size_t)u.pm * 256 + wr * 64 + fr; const int cl = wc * 32 + 8 * fq; const int pn = u.pn;
        bf16* dst; int ld; bool act = false, stats = false;
        if (pn < 4) { dst = mix + pn * 256; ld = 2048; act = true; }
        else if (pn < 8) { dst = gv + (pn - 4) * 256; ld = 1024; act = true; stats = true; }
        else if (pn < 12) { dst = mix + 1024 + (pn - 8) * 256; ld = 2048; }
        else { dst = xbc + (pn - 12) * 256; ld = 2048; }
#pragma unroll
        for (int ai = 0; ai < 2; ++ai)
#pragma unroll
            for (int m = 0; m < 4; ++m) {
                const size_t row = row0 + ai * 128 + m * 16; const float rs = row_rstd(ssp, row, fq);
                float s1 = 0.f, s2 = 0.f;
#pragma unroll
                for (int bj = 0; bj < 2; ++bj) {
                    f32x4 v0 = acc[ai][bj][m][0] * rs, v1 = acc[ai][bj][m][1] * rs;
                    if (act) {
#pragma unroll
                        for (int j = 0; j < 4; ++j) { v0[j] = gelu_t(v0[j]); v1[j] = gelu_t(v1[j]); }
                    }
                    if (stats) {
#pragma unroll
                        for (int j = 0; j < 4; ++j) { s1 += v0[j] + v1[j]; s2 += v0[j] * v0[j] + v1[j] * v1[j]; }
                    }
                    u32x4 w; w.x = pk2(v0[0], v0[1]); w.y = pk2(v0[2], v0[3]); w.z = pk2(v1[0], v1[1]); w.w = pk2(v1[2], v1[3]);
                    *(u32x4*)(dst + row * ld + bj * 128 + cl) = w;
                }
                if (stats) {
                    s1 += __shfl_xor(s1, 16); s1 += __shfl_xor(s1, 32); s2 += __shfl_xor(s2, 16); s2 += __shfl_xor(s2, 32);
                    if (fq == 0) { f32x2 o; o.x = s1; o.y = s2; *(f32x2*)(lnp + (row * 16 + (pn - 4) * 4 + wc) * 2) = o; }
                }
            }
    }
};
struct EpiResid {
    static constexpr bool PERM = true, AFTER_DRAIN = false;
    bf16* xb; float* ssp; const float* bias;
    __device__ __forceinline__ void operator()(const f32x4 (&acc)[2][2][4][2], const pg8::Unit& u, int wr, int wc, int fr, int fq) const {
        const size_t row0 = (size_t)u.pm * 256 + wr * 64 + fr; const int col0 = u.pn * 256 + wc * 32 + 8 * fq;
        f32x4 bv[2][2];
#pragma unroll
        for (int bj = 0; bj < 2; ++bj)
#pragma unroll
            for (int n = 0; n < 2; ++n) bv[bj][n] = bias ? *(const f32x4*)(bias + col0 + bj * 128 + 4 * n) : (f32x4){0.f, 0.f, 0.f, 0.f};
#pragma unroll
        for (int ai = 0; ai < 2; ++ai)
#pragma unroll
            for (int m = 0; m < 4; ++m) {
                const size_t row = row0 + ai * 128 + m * 16; float ss = 0.f;
#pragma unroll
                for (int bj = 0; bj < 2; ++bj) {
                    const size_t off = row * 1024 + col0 + bj * 128;
                    const u32x4 rv = *(const u32x4*)(xb + off);
                    f32x4 v0 = acc[ai][bj][m][0] + bv[bj][0], v1 = acc[ai][bj][m][1] + bv[bj][1];
                    v0[0] += bflo(rv.x); v0[1] += bfhi(rv.x); v0[2] += bflo(rv.y); v0[3] += bfhi(rv.y); v1[0] += bflo(rv.z); v1[1] += bfhi(rv.z); v1[2] += bflo(rv.w); v1[3] += bfhi(rv.w);
#pragma unroll
                    for (int j = 0; j < 4; ++j) ss += v0[j] * v0[j] + v1[j] * v1[j];
                    u32x4 w; w.x = pk2(v0[0], v0[1]); w.y = pk2(v0[2], v0[3]); w.z = pk2(v1[0], v1[1]); w.w = pk2(v1[2], v1[3]);
                    *(u32x4*)(xb + off) = w;
                }
                ss += __shfl_xor(ss, 16); ss += __shfl_xor(ss, 32);
                if (fq == 0) ssp[row * 16 + u.pn * 4 + wc] = ss;
            }
    }
};
struct EpiRelu2 {
    static constexpr bool PERM = true, AFTER_DRAIN = false;
    const float* ssp; bf16* hid;
    __device__ __forceinline__ void operator()(const f32x4 (&acc)[2][2][4][2], const pg8::Unit& u, int wr, int wc, int fr, int fq) const {
        const size_t row0 = (size_t)u.pm * 256 + wr * 64 + fr; const int col0 = u.pn * 256 + wc * 32 + 8 * fq;
#pragma unroll
        for (int ai = 0; ai < 2; ++ai)
#pragma unroll
            for (int m = 0; m < 4; ++m) {
                const size_t row = row0 + ai * 128 + m * 16; const float rs = row_rstd(ssp, row, fq);
#pragma unroll
                for (int bj = 0; bj < 2; ++bj) {
                    f32x4 v0 = acc[ai][bj][m][0] * rs, v1 = acc[ai][bj][m][1] * rs;
#pragma unroll
                    for (int j = 0; j < 4; ++j) { const float a = fmaxf(v0[j], 0.f), b = fmaxf(v1[j], 0.f); v0[j] = a * a; v1[j] = b * b; }
                    u32x4 w; w.x = pk2(v0[0], v0[1]); w.y = pk2(v0[2], v0[3]); w.z = pk2(v1[0], v1[1]); w.w = pk2(v1[2], v1[3]);
                    *(u32x4*)(hid + row * HIDP + col0 + bj * 128) = w;
                }
            }
    }
};
struct EpiQKV {
    static constexpr bool PERM = true, AFTER_DRAIN = false;
    const float* ssp; bf16* o; const float* bias;
    __device__ __forceinline__ void operator()(const f32x4 (&acc)[2][2][4][2], const pg8::Unit& u, int wr, int wc, int fr, int fq) const {
        const size_t row0 = (size_t)u.pm * 256 + wr * 64 + fr; const int col0 = u.pn * 256 + wc * 32 + 8 * fq;
        f32x4 bv[2][2];
#pragma unroll
        for (int bj = 0; bj < 2; ++bj)
#pragma unroll
            for (int n = 0; n < 2; ++n) bv[bj][n] = *(const f32x4*)(bias + col0 + bj * 128 + 4 * n);
#pragma unroll
        for (int ai = 0; ai < 2; ++ai)
#pragma unroll
            for (int m = 0; m < 4; ++m) {
                const size_t row = row0 + ai * 128 + m * 16; const float rs = row_rstd(ssp, row, fq);
#pragma unroll
                for (int bj = 0; bj < 2; ++bj) {
                    const f32x4 v0 = acc[ai][bj][m][0] * rs + bv[bj][0], v1 = acc[ai][bj][m][1] * rs + bv[bj][1];
                    u32x4 w; w.x = pk2(v0[0], v0[1]); w.y = pk2(v0[2], v0[3]); w.z = pk2(v1[0], v1[1]); w.w = pk2(v1[2], v1[3]);
                    *(u32x4*)(o + row * QKVD + col0 + bj * 128) = w;
                }
            }
    }
};

__device__ __forceinline__ void p0_transpose_item(const float* __restrict__ W, int ldw, int K, int nblk, bf16* WT, const float* __restrict__ gain, LAS float* scr, int item, int lane) {
    const int kb = item / nblk, nb = item % nblk, k0 = 64 * kb, n0 = 32 * nb;
#pragma unroll
    for (int i = 0; i < 32; ++i) { const int kk = 2 * i + (lane >> 5); const float gs = gain ? gain[k0 + kk] : 1.f; scr[kk * 33 + (lane & 31)] = W[(size_t)(k0 + kk) * ldw + n0 + (lane & 31)] * gs; }
    LDS_WAIT(); asm volatile("" ::: "memory");
    const int c = lane & 7;
#pragma unroll
    for (int j = 0; j < 4; ++j) { const int n = (lane >> 3) + 8 * j; const LAS float* s = scr + (8 * c) * 33 + n;
        u32x4 o; o.x = pk2(s[0 * 33], s[1 * 33]); o.y = pk2(s[2 * 33], s[3 * 33]); o.z = pk2(s[4 * 33], s[5 * 33]); o.w = pk2(s[6 * 33], s[7 * 33]);
        *(u32x4*)(WT + (size_t)(n0 + n) * K + k0 + 8 * c) = o; }
    LDS_WAIT(); asm volatile("" ::: "memory");
}

__device__ __forceinline__ void phase0(const Args& a, LAS unsigned char* lds, int tid, int lane, int wave, int G) {
    const float* x = a.in[0]; const float* g_mix = a.in[1]; const float* g_mlp = a.in[2]; const float* w_in = a.in[4]; const float* w_out = a.in[5];
    const float* gm_w = a.in[8]; const float* dt_bias = a.in[12]; const float* w_qkv = a.in[16]; const float* w_o = a.in[18]; const float* w_up = a.in[21]; const float* w_dn = a.in[22];
    unsigned char* ws = a.ws;
    bf16* XB = (bf16*)(ws + WS_XB); float* DT = (float*)(ws + WS_DT); float* SSP = (float*)(ws + WS_SSP);
    for (int idx = tid; idx < 16384; idx += 512) { const int k = idx >> 4, j = idx & 15; const float v = w_in[(size_t)k * INEV + NPROJ + j] * g_mix[k]; st16(lds, (j * 1032 + k) * 2, pk2(v, v)); }
    __syncthreads();
    const int gw = blockIdx.x * 8 + wave, NGW = G * 8;
    for (int item = gw; item < MTOK / 16; item += NGW) {
        const int r = lane & 15, q = lane >> 4; const size_t row = (size_t)item * 16 + r;
        const float* xp = x + row * DM + q * 8; bf16* xo = XB + row * DM + q * 8;
        f32x4 acc = {0.f, 0.f, 0.f, 0.f}; float ss = 0.f;
#pragma unroll 8
        for (int kk = 0; kk < 32; ++kk) {
            const f32x4 v0 = *(const f32x4*)(xp + kk * 32), v1 = *(const f32x4*)(xp + kk * 32 + 4);
            ss += (v0.x * v0.x + v0.y * v0.y) + (v0.z * v0.z + v0.w * v0.w) + (v1.x * v1.x + v1.y * v1.y) + (v1.z * v1.z + v1.w * v1.w);
            u32x4 w; w.x = pk2(v0.x, v0.y); w.y = pk2(v0.z, v0.w); w.z = pk2(v1.x, v1.y); w.w = pk2(v1.z, v1.w);
            *(u32x4*)(xo + kk * 32) = w;
            const bf16x8 bfr = lds128(lds, (r * 1032 + kk * 32 + q * 8) * 2);
            acc = mma(acc, __builtin_bit_cast(bf16x8, w), bfr);
        }
        ss += __shfl_xor(ss, 16); ss += __shfl_xor(ss, 32);
        const float rstd = rsqrtf(ss * (1.f / 1024.f) + 1e-5f);
        const f32x4 bias = *(const f32x4*)(dt_bias + q * 4);
        f32x4 o;
#pragma unroll
        for (int j = 0; j < 4; ++j) { const float v = acc[j] * rstd + bias[j]; o[j] = v > 20.f ? v : log1pf(expf(v)); }
        *(f32x4*)(DT + row * 16 + q * 4) = o;
        f32x4 sp = {q == 0 ? ss : 0.f, 0.f, 0.f, 0.f};
        *(f32x4*)(SSP + row * 16 + q * 4) = sp;
    }
    __syncthreads();
    LAS float* scr = (LAS float*)(lds + wave * 16384);
    constexpr int I_IN = 16 * 160, I_OUT = 32 * 32, I_UP = 16 * 128, I_DN = 64 * 32, I_QKV = 16 * 40, I_O = 16 * 32;
    constexpr int NITEMS = I_IN + I_OUT + 2 * I_UP + 2 * I_DN + I_QKV + I_O;
    for (int it = gw; it < NITEMS; it += NGW) {
        int r = it;
        if (r < I_IN) { p0_transpose_item(w_in, INEV, 1024, 160, (bf16*)(ws + WS_WIN), g_mix, scr, r, lane); continue; } r -= I_IN;
        if (r < I_OUT) { p0_transpose_item(w_out, 1024, 2048, 32, (bf16*)(ws + WS_WOUT), nullptr, scr, r, lane); continue; } r -= I_OUT;
        if (r < I_UP) { p0_transpose_item(w_up, 4096, 1024, 128, (bf16*)(ws + WS_WUP0), g_mlp, scr, r, lane); continue; } r -= I_UP;
        if (r < I_UP) { p0_transpose_item(w_up + (size_t)1024 * 4096, 4096, 1024, 128, (bf16*)(ws + WS_WUP1), g_mlp + 1024, scr, r, lane); continue; } r -= I_UP;
        if (r < I_DN) { p0_transpose_item(w_dn, 1024, 4096, 32, (bf16*)(ws + WS_WDN0), nullptr, scr, r, lane); continue; } r -= I_DN;
        if (r < I_DN) { p0_transpose_item(w_dn + (size_t)4096 * 1024, 1024, 4096, 32, (bf16*)(ws + WS_WDN1), nullptr, scr, r, lane); continue; } r -= I_DN;
        if (r < I_QKV) { p0_transpose_item(w_qkv, 1280, 1024, 40, (bf16*)(ws + WS_WQKV), g_mix + 1024, scr, r, lane); continue; } r -= I_QKV;
        p0_transpose_item(w_o, 1024, 1024, 32, (bf16*)(ws + WS_WO), nullptr, scr, r, lane);
    }
    bf16* WGM = (bf16*)(ws + WS_WGM);
    for (int idx = blockIdx.x * 512 + tid; idx < 8 * 128 * 128; idx += G * 512) { const int t = (idx >> 7) & 127, s = idx & 127; const float v = (s <= t) ? gm_w[idx] : 0.f; WGM[idx] = (bf16)(pk2(v, v) & 0xffffu); }
}

__device__ __forceinline__ void conv8(const bf16* __restrict__ XBC, size_t grow0, int l, bool first, int col, const float* __restrict__ cw, const float* __restrict__ cb, float (&o)[8]) {
    const f32x4 b0 = *(const f32x4*)(cb + col), b1 = *(const f32x4*)(cb + col + 4);
    o[0] = b0.x; o[1] = b0.y; o[2] = b0.z; o[3] = b0.w; o[4] = b1.x; o[5] = b1.y; o[6] = b1.z; o[7] = b1.w;
#pragma unroll
    for (int tap = 0; tap < 4; ++tap) {
        const int t = l - 3 + tap;
        u32x4 v = {0u, 0u, 0u, 0u};
        if (!first || t >= 0) v = *(const u32x4*)(XBC + (size_t)((long)grow0 + t) * 2048 + col);
        const f32x4 w0 = *(const f32x4*)(cw + tap * 2048 + col), w1 = *(const f32x4*)(cw + tap * 2048 + col + 4);
        o[0] += w0.x * bflo(v.x); o[1] += w0.y * bfhi(v.x); o[2] += w0.z * bflo(v.y); o[3] += w0.w * bfhi(v.y);
        o[4] += w1.x * bflo(v.z); o[5] += w1.y * bfhi(v.z); o[6] += w1.z * bflo(v.w); o[7] += w1.w * bfhi(v.w);
    }
#pragma unroll
    for (int e = 0; e < 8; ++e) o[e] = silu(o[e]);
}
__device__ __forceinline__ void conv8x8(const bf16* __restrict__ XBC, size_t grow0, int l0, bool first, int col, const float* __restrict__ cw, const float* __restrict__ cb, float (&o)[8][8]) {
    float w[4][8];
#pragma unroll
    for (int tap = 0; tap < 4; ++tap) { const f32x4 w0 = *(const f32x4*)(cw + tap * 2048 + col), w1 = *(const f32x4*)(cw + tap * 2048 + col + 4);
        w[tap][0] = w0.x; w[tap][1] = w0.y; w[tap][2] = w0.z; w[tap][3] = w0.w; w[tap][4] = w1.x; w[tap][5] = w1.y; w[tap][6] = w1.z; w[tap][7] = w1.w; }
    { const f32x4 b0 = *(const f32x4*)(cb + col), b1 = *(const f32x4*)(cb + col + 4);
#pragma unroll
      for (int j = 0; j < 8; ++j) { o[j][0] = b0.x; o[j][1] = b0.y; o[j][2] = b0.z; o[j][3] = b0.w; o[j][4] = b1.x; o[j][5] = b1.y; o[j][6] = b1.z; o[j][7] = b1.w; } }
#pragma unroll
    for (int rr = 0; rr < 11; ++rr) {
        const int t = l0 - 3 + rr;
        u32x4 v = {0u, 0u, 0u, 0u};
        if (!first || t >= 0) v = *(const u32x4*)(XBC + (size_t)((long)grow0 + t) * 2048 + col);
        float x[8];
        x[0] = bflo(v.x); x[1] = bfhi(v.x); x[2] = bflo(v.y); x[3] = bfhi(v.y); x[4] = bflo(v.z); x[5] = bfhi(v.z); x[6] = bflo(v.w); x[7] = bfhi(v.w);
#pragma unroll
        for (int tap = 0; tap < 4; ++tap) { const int j = rr - tap; if (j >= 0 && j < 8) {
#pragma unroll
            for (int e = 0; e < 8; ++e) o[j][e] += w[tap][e] * x[e]; } }
    }
#pragma unroll
    for (int j = 0; j < 8; ++j)
#pragma unroll
        for (int e = 0; e < 8; ++e) o[j][e] = silu(o[j][e]);
}
__device__ __forceinline__ float ssd_scan(const float* __restrict__ DT, const float* __restrict__ a_log, size_t grow0, int h, int r, int lane, LAS float* acum, LAS float* dts, float& a0o, float& a1o, float& d0o, float& d1o) {
    const float A = -expf(a_log[h]);
    const float d0 = DT[(grow0 + 2 * lane) * 16 + h], d1 = DT[(grow0 + 2 * lane + 1) * 16 + h];
    const float v0 = d0 * A, v1 = d1 * A, s = v0 + v1;
    float inc = s;
#pragma unroll
    for (int o = 1; o < 64; o <<= 1) { const float t = __shfl_up(inc, o); if (lane >= o) inc += t; }
    const float exc = inc - s, a0 = exc + v0, a1 = exc + s;
    acum[r * 128 + 2 * lane] = a0; acum[r * 128 + 2 * lane + 1] = a1; dts[r * 128 + 2 * lane] = d0; dts[r * 128 + 2 * lane + 1] = d1;
    a0o = a0; a1o = a1; d0o = d0; d1o = d1;
    return __shfl(a1, 63);
}

__device__ __forceinline__ void ssd_a_tile(const Args& a, LAS unsigned char* lds, int tile, int tid, int lane, int wave) {
    { int tz; asm volatile("v_mov_b32 %0, 0" : "=v"(tz)); tid += tz; lane += tz; }
    constexpr int XST = 0, BT = 69632, ACUM = 104448, DTS = ACUM + 2048, TOE = DTS + 2048;
    const int g = tile & 3, bc = tile >> 2, c = bc & 31; const size_t grow0 = (size_t)bc * 128;
    unsigned char* ws = a.ws; const bf16* XBC = (const bf16*)(ws + WS_XBC); const float* DT = (const float*)(ws + WS_DT); float* DEC = (float*)(ws + WS_DEC); bf16* ST = (bf16*)(ws + WS_ST);
    const float* cw = a.in[10]; const float* cb = a.in[11]; const float* a_log = a.in[13];
    if (wave < 4) {
        float a0, a1, d0, d1; const float tot = ssd_scan(DT, a_log, grow0, g * 4 + wave, wave, lane, (LAS float*)(lds + ACUM), (LAS float*)(lds + DTS), a0, a1, d0, d1);
        LAS float* toe = (LAS float*)(lds + TOE);
        toe[wave * 128 + 2 * lane] = ex(tot - a0) * d0; toe[wave * 128 + 2 * lane + 1] = ex(tot - a1) * d1;
        if (lane == 0) DEC[bc * 16 + g * 4 + wave] = ex(tot);
    }
    __syncthreads();
    {
        const bool first = (c == 0);
        float o[8][8];
        {
            const int chg = tid & 31, l0 = (tid >> 5) * 8;
            conv8x8(XBC, grow0, l0, first, g * 256 + chg * 8, cw, cb, o);
            const LAS float* toe = (const LAS float*)(lds + TOE) + (chg >> 3) * 128 + l0;
            const f32x4 t0 = *(const LAS f32x4*)toe, t1 = *(const LAS f32x4*)(toe + 4);
#pragma unroll
            for (int e = 0; e < 8; ++e) {
                u32x4 w; w.x = pk2(o[0][e] * t0.x, o[1][e] * t0.y); w.y = pk2(o[2][e] * t0.z, o[3][e] * t0.w); w.z = pk2(o[4][e] * t1.x, o[5][e] * t1.y); w.w = pk2(o[6][e] * t1.z, o[7][e] * t1.w);
                *(LAS u32x4*)(lds + XST + ((chg * 8 + e) * 136 + l0) * 2) = w;
            }
        }
        if (tid < 256) {
            const int chg = tid & 15, l0 = (tid >> 4) * 8;
            conv8x8(XBC, grow0, l0, first, 1024 + g * 128 + chg * 8, cw, cb, o);
#pragma unroll
            for (int e = 0; e < 8; ++e) {
                u32x4 w; w.x = pk2(o[0][e], o[1][e]); w.y = pk2(o[2][e], o[3][e]); w.z = pk2(o[4][e], o[5][e]); w.w = pk2(o[6][e], o[7][e]);
                *(LAS u32x4*)(lds + BT + ((chg * 8 + e) * 136 + l0) * 2) = w;
            }
        }
    }
    __syncthreads();
    {
        const int r = wave >> 1, ph = wave & 1, lr = lane & 15, q = lane >> 4;
        f32x4 acc[2][8];
#pragma unroll
        for (int mt = 0; mt < 2; ++mt)
#pragma unroll
            for (int nt = 0; nt < 8; ++nt) acc[mt][nt] = (f32x4){0.f, 0.f, 0.f, 0.f};
#pragma unroll
        for (int ks = 0; ks < 4; ++ks) {
            bf16x8 af[2];
#pragma unroll
            for (int mt = 0; mt < 2; ++mt) af[mt] = lds128(lds, XST + ((r * 64 + ph * 32 + mt * 16 + lr) * 136 + ks * 32 + q * 8) * 2);
#pragma unroll
            for (int nt = 0; nt < 8; ++nt) {
                const bf16x8 bfr = lds128(lds, BT + ((nt * 16 + lr) * 136 + ks * 32 + q * 8) * 2);
#pragma unroll
                for (int mt = 0; mt < 2; ++mt) acc[mt][nt] = mma(acc[mt][nt], af[mt], bfr);
            }
        }
        bf16* stp = ST + ((size_t)bc * 16 + g * 4 + r) * 8192;
#pragma unroll
        for (int mt = 0; mt < 2; ++mt)
#pragma unroll
            for (int nt = 0; nt < 8; ++nt) {
                const int p = ph * 32 + mt * 16 + lr, n = nt * 16 + q * 4;
                u32x2 w; w.x = pk2(acc[mt][nt][0], acc[mt][nt][1]); w.y = pk2(acc[mt][nt][2], acc[mt][nt][3]);
                *(u32x2*)(stp + p * 128 + n) = w;
            }
    }
    __syncthreads();
}

__device__ __forceinline__ void gmlp_tile(const Args& a, LAS unsigned char* lds, int tile, int tid, int lane, int wave) {
    constexpr int VNT = 0;
    const int g = tile & 7, bc = tile >> 3; const size_t grow0 = (size_t)bc * 128;
    unsigned char* ws = a.ws; const bf16* GV = (const bf16*)(ws + WS_GV); const float* LNP = (const float*)(ws + WS_LNP); bf16* MIX = (bf16*)(ws + WS_MIX); const bf16* WGM = (const bf16*)(ws + WS_WGM);
    const float* ln_g = a.in[6]; const float* ln_b = a.in[7]; const float* b_s = a.in[9];
    {
        const int srow = tid >> 2, part = tid & 3; const size_t row = grow0 + srow;
        const f32x4 p0 = *(const f32x4*)(LNP + row * 32 + part * 8), p1 = *(const f32x4*)(LNP + row * 32 + part * 8 + 4);
        float s1 = (p0.x + p0.z) + (p1.x + p1.z), s2 = (p0.y + p0.w) + (p1.y + p1.w);
        s1 += __shfl_xor(s1, 1); s1 += __shfl_xor(s1, 2); s2 += __shfl_xor(s2, 1); s2 += __shfl_xor(s2, 2);
        const float mean = s1 * (1.f / 1024.f), var = s2 * (1.f / 1024.f) - mean * mean, rstd = rsqrtf(var + 1e-5f);
        if (part == 0) { f32x2 ms; ms.x = mean; ms.y = rstd; *(LAS f32x2*)(lds + 34816 + srow * 8) = ms; }
    }
    __syncthreads();
    {
        const int chg = tid & 15, s0 = (tid >> 4) * 4, ch = g * 128 + chg * 8;
        const f32x4 g0 = *(const f32x4*)(ln_g + ch), g1 = *(const f32x4*)(ln_g + ch + 4), c0 = *(const f32x4*)(ln_b + ch), c1 = *(const f32x4*)(ln_b + ch + 4);
        float val[4][8];
#pragma unroll
        for (int jj = 0; jj < 4; ++jj) {
            const u32x4 v = *(const u32x4*)(GV + (grow0 + s0 + jj) * 1024 + ch);
            const f32x2 ms = *(const LAS f32x2*)(lds + 34816 + (s0 + jj) * 8);
            const float mean = ms.x, rstd = ms.y;
            val[jj][0] = (bflo(v.x) - mean) * rstd * g0.x + c0.x; val[jj][1] = (bfhi(v.x) - mean) * rstd * g0.y + c0.y; val[jj][2] = (bflo(v.y) - mean) * rstd * g0.z + c0.z; val[jj][3] = (bfhi(v.y) - mean) * rstd * g0.w + c0.w;
            val[jj][4] = (bflo(v.z) - mean) * rstd * g1.x + c1.x; val[jj][5] = (bfhi(v.z) - mean) * rstd * g1.y + c1.y; val[jj][6] = (bflo(v.w) - mean) * rstd * g1.z + c1.z; val[jj][7] = (bfhi(v.w) - mean) * rstd * g1.w + c1.w;
        }
#pragma unroll
        for (int e = 0; e < 8; ++e) { u32x2 w; w.x = pk2(val[0][e], val[1][e]); w.y = pk2(val[2][e], val[3][e]); *(LAS u32x2*)(lds + VNT + ((chg * 8 + e) * 136 + s0) * 2) = w; }
    }
    __syncthreads();
    {
        const int wr = wave >> 1, wc = wave & 1, lr = lane & 15, q = lane >> 4;
        f32x4 acc[2][4];
#pragma unroll
        for (int mt = 0; mt < 2; ++mt)
#pragma unroll
            for (int nt = 0; nt < 4; ++nt) acc[mt][nt] = (f32x4){0.f, 0.f, 0.f, 0.f};
        for (int ks = 0; ks <= wr; ++ks) {
            bf16x8 af[2];
#pragma unroll
            for (int mt = 0; mt < 2; ++mt) af[mt] = *(const bf16x8*)(WGM + g * 16384 + (wr * 32 + mt * 16 + lr) * 128 + ks * 32 + q * 8);
#pragma unroll
            for (int nt = 0; nt < 4; ++nt) {
                const bf16x8 bfr = lds128(lds, VNT + ((wc * 64 + nt * 16 + lr) * 136 + ks * 32 + q * 8) * 2);
#pragma unroll
                for (int mt = 0; mt < 2; ++mt) acc[mt][nt] = mma(acc[mt][nt], af[mt], bfr);
            }
        }
#pragma unroll
        for (int mt = 0; mt < 2; ++mt) {
            const int t = wr * 32 + mt * 16 + lr; const float bias = b_s[g * 128 + t];
#pragma unroll
            for (int nt = 0; nt < 4; ++nt) {
                bf16* p = MIX + (grow0 + t) * 2048 + g * 128 + wc * 64 + nt * 16 + q * 4;
                const u32x2 uu = *(const u32x2*)p;
                u32x2 w; w.x = pk2((acc[mt][nt][0] + bias) * bflo(uu.x), (acc[mt][nt][1] + bias) * bfhi(uu.x)); w.y = pk2((acc[mt][nt][2] + bias) * bflo(uu.y), (acc[mt][nt][3] + bias) * bfhi(uu.y));
                *(u32x2*)p = w;
            }
        }
    }
    __syncthreads();
}

__device__ __forceinline__ void scan_phase(const Args& a, int tid, int G) {
    bf16* ST = (bf16*)(a.ws + WS_ST); const float* DEC = (const float*)(a.ws + WS_DEC);
    for (int idx = blockIdx.x * 512 + tid; idx < 131072; idx += G * 512) {
        const int pn8 = idx & 1023, h = (idx >> 10) & 15, b = idx >> 14;
        float st[8];
#pragma unroll
        for (int e = 0; e < 8; ++e) st[e] = 0.f;
#pragma unroll 1
        for (int c0 = 0; c0 < 32; c0 += 8) {
            u32x4 v[8]; float dec[8];
#pragma unroll
            for (int cc = 0; cc < 8; ++cc) { const size_t bch = ((size_t)(b * 32 + c0 + cc)) * 16 + h; v[cc] = *(const u32x4*)(ST + bch * 8192 + pn8 * 8); dec[cc] = DEC[bch]; }
#pragma unroll
            for (int cc = 0; cc < 8; ++cc) {
                const size_t bch = ((size_t)(b * 32 + c0 + cc)) * 16 + h;
                u32x4 w; w.x = pk2(st[0], st[1]); w.y = pk2(st[2], st[3]); w.z = pk2(st[4], st[5]); w.w = pk2(st[6], st[7]);
                *(u32x4*)(ST + bch * 8192 + pn8 * 8) = w;
                const float d = dec[cc];
                st[0] = d * st[0] + bflo(v[cc].x); st[1] = d * st[1] + bfhi(v[cc].x); st[2] = d * st[2] + bflo(v[cc].y); st[3] = d * st[3] + bfhi(v[cc].y);
                st[4] = d * st[4] + bflo(v[cc].z); st[5] = d * st[5] + bfhi(v[cc].z); st[6] = d * st[6] + bflo(v[cc].w); st[7] = d * st[7] + bfhi(v[cc].w);
            }
        }
    }
}

__device__ __forceinline__ void ssd_b_tile(const Args& a, LAS unsigned char* lds, int tile, int tid, int lane, int wave) {
    { int tz; asm volatile("v_mov_b32 %0, 0" : "=v"(tz)); tid += tz; lane += tz; }
    constexpr int XST = 0, CM = 69632, BM = 104448, ACUM = 139264, DTS = ACUM + 2048, PSS = DTS + 2048;
    const int g = tile & 3, bc = tile >> 2, c = bc & 31; const size_t grow0 = (size_t)bc * 128;
    unsigned char* ws = a.ws; const bf16* XBC = (const bf16*)(ws + WS_XBC); const float* DT = (const float*)(ws + WS_DT); const bf16* ST = (const bf16*)(ws + WS_ST); bf16* MIX = (bf16*)(ws + WS_MIX);
    const float* cw = a.in[10]; const float* cb = a.in[11]; const float* a_log = a.in[13]; const float* d_skip = a.in[14]; const float* norm_g = a.in[15];
    if (wave < 4) { float a0, a1, d0, d1; (void)ssd_scan(DT, a_log, grow0, g * 4 + wave, wave, lane, (LAS float*)(lds + ACUM), (LAS float*)(lds + DTS), a0, a1, d0, d1); }
    {
        const bool first = (c == 0);
        float o[8][8];
        {
            const int chg = tid & 31, l0 = (tid >> 5) * 8;
            conv8x8(XBC, grow0, l0, first, g * 256 + chg * 8, cw, cb, o);
#pragma unroll
            for (int e = 0; e < 8; ++e) {
                u32x4 w; w.x = pk2(o[0][e], o[1][e]); w.y = pk2(o[2][e], o[3][e]); w.z = pk2(o[4][e], o[5][e]); w.w = pk2(o[6][e], o[7][e]);
                *(LAS u32x4*)(lds + XST + ((chg * 8 + e) * 136 + l0) * 2) = w;
            }
        }
        {
            const int half = tid >> 8, chg = tid & 15, l0 = ((tid >> 4) & 15) * 8;
            conv8x8(XBC, grow0, l0, first, (half ? 1536 : 1024) + g * 128 + chg * 8, cw, cb, o);
            const int dstb = half ? CM : BM;
#pragma unroll
            for (int j = 0; j < 8; ++j) {
                u32x4 w; w.x = pk2(o[j][0], o[j][1]); w.y = pk2(o[j][2], o[j][3]); w.z = pk2(o[j][4], o[j][5]); w.w = pk2(o[j][6], o[j][7]);
                *(LAS u32x4*)(lds + dstb + ((l0 + j) * 136 + chg * 8) * 2) = w;
            }
        }
    }
    __syncthreads();
    const int lr = lane & 15, q = lane >> 4;
    const int r = wave >> 1, lh = wave & 1, h = g * 4 + r;
    bf16x8 pv[4][4];
    {
        const bf16* prev = ST + ((size_t)bc * 16 + h) * 8192;
#pragma unroll
        for (int ks = 0; ks < 4; ++ks)
#pragma unroll
            for (int nt = 0; nt < 4; ++nt) pv[ks][nt] = *(const bf16x8*)(prev + (nt * 16 + lr) * 128 + ks * 32 + q * 8);
    }
    {
        const int wr4 = wave >> 1, wc2 = wave & 1;
        f32x4 cbv[2][4];
#pragma unroll
        for (int mt = 0; mt < 2; ++mt)
#pragma unroll
            for (int nt = 0; nt < 4; ++nt) cbv[mt][nt] = (f32x4){0.f, 0.f, 0.f, 0.f};
#pragma unroll
        for (int ks = 0; ks < 4; ++ks) {
            bf16x8 af[2];
#pragma unroll
            for (int mt = 0; mt < 2; ++mt) af[mt] = lds128(lds, CM + ((wr4 * 32 + mt * 16 + lr) * 136 + ks * 32 + q * 8) * 2);
#pragma unroll
            for (int nt = 0; nt < 4; ++nt) {
                const bf16x8 bfr = lds128(lds, BM + ((wc2 * 64 + nt * 16 + lr) * 136 + ks * 32 + q * 8) * 2);
#pragma unroll
                for (int mt = 0; mt < 2; ++mt) cbv[mt][nt] = mma(cbv[mt][nt], af[mt], bfr);
            }
        }
        __syncthreads();
#pragma unroll
        for (int mt = 0; mt < 2; ++mt)
#pragma unroll
            for (int nt = 0; nt < 4; ++nt) {
                u32x2 w; w.x = pk2(cbv[mt][nt][0], cbv[mt][nt][1]); w.y = pk2(cbv[mt][nt][2], cbv[mt][nt][3]);
                *(LAS u32x2*)(lds + BM + ((wr4 * 32 + mt * 16 + lr) * 136 + wc2 * 64 + nt * 16 + q * 4) * 2) = w;
            }
        __syncthreads();
    }
    const LAS float* acum = (const LAS float*)(lds + ACUM) + r * 128; const LAS float* dts = (const LAS float*)(lds + DTS) + r * 128;
    f32x4 acc[4][4];
#pragma unroll
    for (int mt = 0; mt < 4; ++mt)
#pragma unroll
        for (int nt = 0; nt < 4; ++nt) acc[mt][nt] = (f32x4){0.f, 0.f, 0.f, 0.f};
    {
#pragma unroll
        for (int ks = 0; ks < 4; ++ks) {
            bf16x8 af[4];
#pragma unroll
            for (int mt = 0; mt < 4; ++mt) af[mt] = lds128(lds, CM + ((lh * 64 + mt * 16 + lr) * 136 + ks * 32 + q * 8) * 2);
#pragma unroll
            for (int nt = 0; nt < 4; ++nt)
#pragma unroll
                for (int mt = 0; mt < 4; ++mt) acc[mt][nt] = mma(acc[mt][nt], af[mt], pv[ks][nt]);
        }
    }
    float al[4];
#pragma unroll
    for (int mt = 0; mt < 4; ++mt) { al[mt] = acum[lh * 64 + mt * 16 + lr]; const float sc = ex(al[mt]);
#pragma unroll
        for (int nt = 0; nt < 4; ++nt) acc[mt][nt] = acc[mt][nt] * sc; }
#pragma unroll 1
    for (int ks = 0; ks <= lh * 2 + 1; ++ks) {
        const int s0 = ks * 32 + q * 8;
        const f32x4 as0 = *(const LAS f32x4*)(acum + s0), as1 = *(const LAS f32x4*)(acum + s0 + 4), dd0 = *(const LAS f32x4*)(dts + s0), dd1 = *(const LAS f32x4*)(dts + s0 + 4);
        bf16x8 bx[4];
#pragma unroll
        for (int nt = 0; nt < 4; ++nt) bx[nt] = lds128(lds, XST + ((r * 64 + nt * 16 + lr) * 136 + s0) * 2);
#pragma unroll
        for (int mt = 0; mt < 4; ++mt) {
            if (lh * 64 + mt * 16 + 15 < ks * 32) continue;
            const int l = lh * 64 + mt * 16 + lr;
            const u32x4 raw = *(const LAS u32x4*)(lds + BM + (l * 136 + s0) * 2);
            float w[8];
            w[0] = bflo(raw.x); w[1] = bfhi(raw.x); w[2] = bflo(raw.y); w[3] = bfhi(raw.y); w[4] = bflo(raw.z); w[5] = bfhi(raw.z); w[6] = bflo(raw.w); w[7] = bfhi(raw.w);
#pragma unroll
            for (int e = 0; e < 8; ++e) {
                const float as = e < 4 ? as0[e & 3] : as1[e & 3], dd = e < 4 ? dd0[e & 3] : dd1[e & 3];
                const bool valid = (s0 + e) <= l;
                const float arg = valid ? (al[mt] - as) : 0.f;
                w[e] = valid ? w[e] * ex(arg) * dd : 0.f;
            }
            u32x4 pw; pw.x = pk2(w[0], w[1]); pw.y = pk2(w[2], w[3]); pw.z = pk2(w[4], w[5]); pw.w = pk2(w[6], w[7]);
            const bf16x8 af = __builtin_bit_cast(bf16x8, pw);
#pragma unroll
            for (int nt = 0; nt < 4; ++nt) acc[mt][nt] = mma(acc[mt][nt], af, bx[nt]);
        }
    }
    const float dsk = d_skip[h];
#pragma unroll
    for (int mt = 0; mt < 4; ++mt) {
        const int l = lh * 64 + mt * 16 + lr; float ssq = 0.f;
#pragma unroll
        for (int nt = 0; nt < 4; ++nt) {
            const int ch = r * 64 + nt * 16 + q * 4;
            const u32x2 zz = *(const u32x2*)(MIX + (grow0 + l) * 2048 + 1024 + g * 256 + ch);
            float xs[4], zf[4];
            zf[0] = bflo(zz.x); zf[1] = bfhi(zz.x); zf[2] = bflo(zz.y); zf[3] = bfhi(zz.y);
#pragma unroll
            for (int j = 0; j < 4; ++j) xs[j] = __uint_as_float(((unsigned)*(const LAS unsigned short*)(lds + XST + ((ch + j) * 136 + l) * 2)) << 16);
#pragma unroll
            for (int j = 0; j < 4; ++j) { const float y = (acc[mt][nt][j] + dsk * xs[j]) * silu(zf[j]); acc[mt][nt][j] = y; ssq += y * y; }
        }
        ssq += __shfl_xor(ssq, 16); ssq += __shfl_xor(ssq, 32);
        if (q == 0) ((LAS float*)(lds + PSS))[r * 128 + l] = ssq;
        __builtin_amdgcn_sched_barrier(0);
    }
    __syncthreads();
#pragma unroll
    for (int mt = 0; mt < 4; ++mt) {
        const int l = lh * 64 + mt * 16 + lr; const LAS float* pss = (const LAS float*)(lds + PSS);
        const float tot = (pss[l] + pss[128 + l]) + (pss[256 + l] + pss[384 + l]);
        const float rs = rsqrtf(tot * (1.f / 256.f) + 1e-5f);
#pragma unroll
        for (int nt = 0; nt < 4; ++nt) {
            const int ch = r * 64 + nt * 16 + q * 4;
            const f32x4 ng = *(const f32x4*)(norm_g + g * 256 + ch);
            u32x2 w; w.x = pk2(acc[mt][nt][0] * rs * ng.x, acc[mt][nt][1] * rs * ng.y); w.y = pk2(acc[mt][nt][2] * rs * ng.z, acc[mt][nt][3] * rs * ng.w);
            *(u32x2*)(MIX + (grow0 + l) * 2048 + 1024 + g * 256 + ch) = w;
        }
        __builtin_amdgcn_sched_barrier(0);
    }
    __syncthreads();
}

__device__ __forceinline__ void attn_tile(const Args& a, LAS unsigned char* lds, int tile, int tid, int lane, int wave) {
    constexpr int KB = 0, VT = 36864;
    const int kvh = tile & 1, bn = tile >> 1, nb = bn & 31;
    const bf16* QKV = (const bf16*)(a.ws + WS_QKV); bf16* ATT = (bf16*)(a.ws + WS_ATT); const float* sinks = a.in[20];
    if (tid < 256) {
        const int d0 = (tid & 7) * 8, s0 = (tid >> 3) * 8;
        u32x4 v[8];
#pragma unroll
        for (int j = 0; j < 8; ++j) { const int sk = s0 + j; v[j] = (u32x4){0u, 0u, 0u, 0u};
            if (nb > 0 || sk >= 128) v[j] = *(const u32x4*)(QKV + ((long)bn * 128 - 128 + sk) * QKVD + 1152 + kvh * 64 + d0); }
#pragma unroll
        for (int e = 0; e < 8; ++e) {
            unsigned hh[8];
#pragma unroll
            for (int j = 0; j < 8; ++j) { const unsigned wd = v[j][e >> 1]; hh[j] = (e & 1) ? (wd >> 16) : (wd & 0xffffu); }
            u32x4 w; w.x = hh[0] | (hh[1] << 16); w.y = hh[2] | (hh[3] << 16); w.z = hh[4] | (hh[5] << 16); w.w = hh[6] | (hh[7] << 16);
            *(LAS u32x4*)(lds + VT + ((d0 + e) * 264 + s0) * 2) = w;
        }
    } else {
        const int t2 = tid - 256;
#pragma unroll
        for (int i = 0; i < 8; ++i) {
            const int p = t2 + 256 * i, sk = p >> 3, pc = p & 7;
            u32x4 kv = {0u, 0u, 0u, 0u};
            if (nb > 0 || sk >= 128) kv = *(const u32x4*)(QKV + ((long)bn * 128 - 128 + sk) * QKVD + 1024 + kvh * 64 + pc * 8);
            *(LAS u32x4*)(lds + KB + (sk * 72 + pc * 8) * 2) = kv;
        }
    }
    __syncthreads();
    const int h = kvh * 8 + wave, lr = lane & 15, q4 = lane >> 4; const float sink = sinks[h];
    bf16x8 aqn[2];
#pragma unroll
    for (int ks = 0; ks < 2; ++ks) aqn[ks] = *(const bf16x8*)(QKV + ((size_t)bn * 128 + lr) * QKVD + h * 64 + ks * 32 + q4 * 8);
#pragma unroll 1
    for (int qc = 0; qc < 8; ++qc) {
        const int qi = qc * 16 + lr; const size_t qrow = (size_t)bn * 128 + qi;
        bf16x8 aq[2];
#pragma unroll
        for (int ks = 0; ks < 2; ++ks) aq[ks] = aqn[ks];
        { const size_t qnext = qrow + (qc < 7 ? 16 : 0);
#pragma unroll
          for (int ks = 0; ks < 2; ++ks) aqn[ks] = *(const bf16x8*)(QKV + qnext * QKVD + h * 64 + ks * 32 + q4 * 8); }
        f32x4 sc[10];
#pragma unroll
        for (int t = 0; t < 9; ++t) {
            sc[t] = (f32x4){0.f, 0.f, 0.f, 0.f};
#pragma unroll
            for (int ks = 0; ks < 2; ++ks) sc[t] = mma(sc[t], aq[ks], lds128(lds, KB + (((qc + t) * 16 + lr) * 72 + ks * 32 + q4 * 8) * 2));
        }
        sc[9] = (f32x4){0.f, 0.f, 0.f, 0.f};
        float m = sink;
#pragma unroll
        for (int t = 0; t < 9; ++t)
#pragma unroll
            for (int j = 0; j < 4; ++j) {
                const int si = (qc + t) * 16 + q4 * 4 + j;
                const bool valid = (si >= qi + 1) && (si <= qi + 128) && (nb > 0 || si >= 128);
                const float v = valid ? sc[t][j] * 0.125f : -INFINITY;
                sc[t][j] = v; m = fmaxf(m, v);
            }
        m = fmaxf(m, __shfl_xor(m, 16)); m = fmaxf(m, __shfl_xor(m, 32));
        float sum = 0.f;
#pragma unroll
        for (int t = 0; t < 9; ++t)
#pragma unroll
            for (int j = 0; j < 4; ++j) { const float p = ex(sc[t][j] - m); sc[t][j] = p; sum += p; }
        sum += __shfl_xor(sum, 16); sum += __shfl_xor(sum, 32);
        const float inv = 1.f / (sum + ex(sink - m));
        f32x4 o[4];
#pragma unroll
        for (int dt = 0; dt < 4; ++dt) o[dt] = (f32x4){0.f, 0.f, 0.f, 0.f};
#pragma unroll
        for (int kk = 0; kk < 5; ++kk) {
            const int t0 = 2 * kk, t1 = 2 * kk + 1;
            u32x4 pw; pw.x = pk2(sc[t0][0], sc[t0][1]); pw.y = pk2(sc[t0][2], sc[t0][3]); pw.z = pk2(sc[t1][0], sc[t1][1]); pw.w = pk2(sc[t1][2], sc[t1][3]);
            const bf16x8 af = __builtin_bit_cast(bf16x8, pw);
            const int T0 = qc + t0, T1 = (qc + t1) > 15 ? 15 : (qc + t1);
#pragma unroll
            for (int dt = 0; dt < 4; ++dt) {
                const u32x2 b0 = *(const LAS u32x2*)(lds + VT + ((dt * 16 + lr) * 264 + T0 * 16 + q4 * 4) * 2), b1 = *(const LAS u32x2*)(lds + VT + ((dt * 16 + lr) * 264 + T1 * 16 + q4 * 4) * 2);
                u32x4 bw; bw.x = b0.x; bw.y = b0.y; bw.z = b1.x; bw.w = b1.y;
                o[dt] = mma(o[dt], af, __builtin_bit_cast(bf16x8, bw));
            }
        }
#pragma unroll
        for (int dt = 0; dt < 4; ++dt) {
            u32x2 w; w.x = pk2(o[dt][0] * inv, o[dt][1] * inv); w.y = pk2(o[dt][2] * inv, o[dt][3] * inv);
            *(u32x2*)(ATT + qrow * 1024 + h * 64 + dt * 16 + q4 * 4) = w;
        }
    }
    __syncthreads();
}

__device__ __forceinline__ float wave_sum(float v) {
#pragma unroll
    for (int o = 1; o < 64; o <<= 1) v += __shfl_xor(v, o);
    return v;
}

#define XB_TMO      128
#define XB_XCNT(j)  (256  + 64 * (j))
#define XB_XSUB(j)  (1280 + 64 * (j))
#define XB_XGEN(j)  (2304 + 64 * (j))
#define XB_TOP      3328
#define XB_TOPGEN   3392
#define XCD_BAR_WORDS 3456
#define XB_SPIN_CAP (1u << 18)

__device__ __forceinline__ unsigned xb_ld(unsigned* p)              { return __hip_atomic_load(p, __ATOMIC_RELAXED, __HIP_MEMORY_SCOPE_AGENT); }
__device__ __forceinline__ unsigned xb_add(unsigned* p, unsigned v) { return __hip_atomic_fetch_add(p, v, __ATOMIC_RELAXED, __HIP_MEMORY_SCOPE_AGENT); }
__device__ __forceinline__ unsigned xb_xcc_id() { return (unsigned)__builtin_amdgcn_s_getreg((3 << 11) | 20) & 0xFu; }
#define XB_SPIN(cond, bar) do { unsigned _sp = 0; while (cond) { __builtin_amdgcn_s_sleep(1); \
    if ((++_sp & 255u) == 0u) { if (xb_ld(&(bar)[XB_TMO])) break; if (_sp > XB_SPIN_CAP) { atomicAdd(&(bar)[XB_TMO], 1u); break; } } } } while (0)

struct XcdBarrier {
    unsigned* bar; unsigned x;
    volatile LAS unsigned* st;
};

__device__ __forceinline__ XcdBarrier xcd_barrier_post(unsigned* bar, volatile LAS unsigned* st) {
    XcdBarrier b; b.bar = bar; b.x = xb_xcc_id(); b.st = st;
    if (threadIdx.x == 0) (void)xb_add(&bar[XB_XCNT(b.x)], 1u);
    return b;
}
__device__ __forceinline__ void xcd_barrier_complete(unsigned* bar, unsigned x, unsigned& nloc, unsigned& nx) {
    const unsigned G = gridDim.x * gridDim.y * gridDim.z;
    unsigned sum, cnt, mine, sp = 0u;
    for (;;) {
        sum = 0u; cnt = 0u; mine = 0u;
#pragma unroll
        for (unsigned j = 0; j < 16; ++j) { const unsigned c = xb_ld(&bar[XB_XCNT(j)]); sum += c; cnt += (c > 0u) ? 1u : 0u; mine = (j == x) ? c : mine; }
        if (sum == G) break;
        __builtin_amdgcn_s_sleep(1);
        if ((++sp & 255u) == 0u) { if (xb_ld(&bar[XB_TMO])) break; if (sp > XB_SPIN_CAP) { atomicAdd(&bar[XB_TMO], 1u); break; } }
    }
    nloc = mine > 0u ? mine : 1u; nx = cnt > 0u ? cnt : 1u;
}

__device__ __forceinline__ void xcd_barrier(const XcdBarrier& b) {
    asm volatile("s_waitcnt vmcnt(0)" ::: "memory");
    __syncthreads();
    if (threadIdx.x == 0) {
        unsigned* bar = b.bar;
        __builtin_amdgcn_s_waitcnt(0);
        unsigned nloc = b.st[0], nx = b.st[1];
        if (nloc == 0u) { xcd_barrier_complete(bar, b.x, nloc, nx); b.st[0] = nloc; b.st[1] = nx; }
        const unsigned old = xb_add(&bar[XB_XSUB(b.x)], 1u);
        const unsigned gen = old / nloc;
        if (old + 1u == (gen + 1u) * nloc) {
            __builtin_amdgcn_fence(__ATOMIC_RELEASE, "agent");
            asm volatile("s_waitcnt vmcnt(0)" ::: "memory");
            const unsigned og = xb_add(&bar[XB_TOP], 1u);
            const unsigned tg = og / nx;
            if (og + 1u == (tg + 1u) * nx) xb_add(&bar[XB_TOPGEN], 1u);
            else XB_SPIN(xb_ld(&bar[XB_TOPGEN]) == tg, bar);
            __builtin_amdgcn_fence(__ATOMIC_ACQUIRE, "agent");
            xb_add(&bar[XB_XGEN(b.x)], 1u);
            asm volatile("s_waitcnt vmcnt(0)" ::: "memory");
        } else {
            XB_SPIN(xb_ld(&bar[XB_XGEN(b.x)]) == gen, bar);
            __builtin_amdgcn_fence(__ATOMIC_ACQUIRE, "agent");
            asm volatile("s_waitcnt vmcnt(0)" ::: "memory");
        }
    }
    __syncthreads();
}

__global__ void __launch_bounds__(512, 2) hybrid_fwd(Args args) {
    extern __shared__ __attribute__((aligned(16))) unsigned char lds_raw[];
    LAS unsigned char* lds = (LAS unsigned char*)lds_raw;
    const int tid = threadIdx.x, lane = tid & 63, wave = __builtin_amdgcn_readfirstlane(tid >> 6), G = gridDim.x;
    unsigned char* ws = args.ws;
    const int lo = args.ph_lo, hi = args.ph_hi;
    cg::grid_group grid = cg::this_grid();
    if (lo > hi) grid.sync();
    volatile LAS unsigned* bst = (volatile LAS unsigned*)(lds + LDS_BYTES - 16);
    if (tid < 4) bst[tid] = 0u;
    __syncthreads();
    XcdBarrier bar = xcd_barrier_post((unsigned*)ws, bst);
#ifndef PH_MASK
#define PH_MASK 0x3fff
#endif
#define IN(k) (((PH_MASK >> (k)) & 1) && lo <= (k) && (k) < hi)
#define SEAM(k) do { if (IN(k) && IN((k) + 1)) { xcd_barrier(bar); } } while (0)
    bf16* XB = (bf16*)(ws + WS_XB); float* SSP = (float*)(ws + WS_SSP); float* H = args.out;

    if (IN(0)) { phase0(args, lds, tid, lane, wave, G); } SEAM(0);
    if (IN(1)) {
        pg8::Gemm g{XB, (const bf16*)(ws + WS_WIN), MTOK, NPROJ, DM}; pg8::StaticOrder S; S.init(MTOK, NPROJ, G, (int)blockIdx.x);
        EpiInProj E{SSP, (bf16*)(ws + WS_MIX), (bf16*)(ws + WS_GV), (bf16*)(ws + WS_XBC), (float*)(ws + WS_LNP)};
        pg8::gemm_phase<EpiInProj, pg8::StaticOrder, true, true>(lds, g, S, E);
    } SEAM(1);
    if (IN(2)) {
        for (int t = blockIdx.x; t < 1024 + 2048; t += G) { if (t < 1024) ssd_a_tile(args, lds, t, tid, lane, wave); else gmlp_tile(args, lds, t - 1024, tid, lane, wave); }
    } SEAM(2);
    if (IN(3)) { scan_phase(args, tid, G); } SEAM(3);
    if (IN(4)) { for (int t = blockIdx.x; t < 1024; t += G) ssd_b_tile(args, lds, t, tid, lane, wave); } SEAM(4);
    if (IN(5)) {
        pg8::Gemm g{(const bf16*)(ws + WS_MIX), (const bf16*)(ws + WS_WOUT), MTOK, DM, 2048}; pg8::StaticOrder S; S.init(MTOK, DM, G, (int)blockIdx.x);
        EpiResid E{XB, SSP, nullptr};
        pg8::gemm_phase<EpiResid, pg8::StaticOrder, true, true>(lds, g, S, E);
    } SEAM(5);
    if (IN(6)) {
        pg8::Gemm g{XB, (const bf16*)(ws + WS_WUP0), MTOK, DFF, DM}; pg8::StaticOrder S; S.init(MTOK, DFF, G, (int)blockIdx.x);
        EpiRelu2 E{SSP, (bf16*)(ws + WS_HID)};
        pg8::gemm_phase<EpiRelu2, pg8::StaticOrder, true, true>(lds, g, S, E);
    } SEAM(6);
    if (IN(7)) {
        pg8::Gemm g{(const bf16*)(ws + WS_HID), (const bf16*)(ws + WS_WDN0), MTOK, DM, DFF, HIDP}; pg8::StaticOrder S; S.init(MTOK, DM, G, (int)blockIdx.x);
        EpiResid E{XB, SSP, nullptr};
        pg8::gemm_phase<EpiResid, pg8::StaticOrder, true, true>(lds, g, S, E);
    } SEAM(7);
    if (IN(8)) {
        pg8::Gemm g{XB, (const bf16*)(ws + WS_WQKV), MTOK, QKVD, DM}; pg8::StaticOrder S; S.init(MTOK, QKVD, G, (int)blockIdx.x);
        EpiQKV E{SSP, (bf16*)(ws + WS_QKV), args.in[17]};
        pg8::gemm_phase<EpiQKV, pg8::StaticOrder, true, true>(lds, g, S, E);
    } SEAM(8);
    if (IN(9)) { for (int t = blockIdx.x; t < 512; t += G) attn_tile(args, lds, t, tid, lane, wave); } SEAM(9);
    if (IN(10)) {
        pg8::Gemm g{(const bf16*)(ws + WS_ATT), (const bf16*)(ws + WS_WO), MTOK, DM, DM}; pg8::StaticOrder S; S.init(MTOK, DM, G, (int)blockIdx.x);
        EpiResid E{XB, SSP, args.in[19]};
        pg8::gemm_phase<EpiResid, pg8::StaticOrder, true, true>(lds, g, S, E);
    } SEAM(10);
    if (IN(11)) {
        pg8::Gemm g{XB, (const bf16*)(ws + WS_WUP1), MTOK, DFF, DM}; pg8::StaticOrder S; S.init(MTOK, DFF, G, (int)blockIdx.x);
        EpiRelu2 E{SSP, (bf16*)(ws + WS_HID)};
        pg8::gemm_phase<EpiRelu2, pg8::StaticOrder, true, true>(lds, g, S, E);
    } SEAM(11);
    if (IN(12)) {
        pg8::Gemm g{(const bf16*)(ws + WS_HID), (const bf16*)(ws + WS_WDN1), MTOK, DM, DFF, HIDP}; pg8::StaticOrder S; S.init(MTOK, DM, G, (int)blockIdx.x);
        EpiResid E{XB, SSP, nullptr};
        pg8::gemm_phase<EpiResid, pg8::StaticOrder, true, true>(lds, g, S, E);
    } SEAM(12);
    if (IN(13)) {
        const float* fg = args.in[3];
        f32x4 gv[2][2];
#pragma unroll
        for (int j = 0; j < 2; ++j) { gv[j][0] = *(const f32x4*)(fg + j * 512 + lane * 8); gv[j][1] = *(const f32x4*)(fg + j * 512 + lane * 8 + 4); }
        for (int m = blockIdx.x * 8 + wave; m < MTOK; m += G * 8) {
            f32x4 v[2][2]; float sq = 0.f;
#pragma unroll
            for (int j = 0; j < 2; ++j) { const u32x4 r = *(const u32x4*)(XB + (size_t)m * DM + j * 512 + lane * 8);
                v[j][0] = (f32x4){bflo(r.x), bfhi(r.x), bflo(r.y), bfhi(r.y)}; v[j][1] = (f32x4){bflo(r.z), bfhi(r.z), bflo(r.w), bfhi(r.w)};
#pragma unroll
                for (int k = 0; k < 2; ++k) sq += (v[j][k].x * v[j][k].x + v[j][k].y * v[j][k].y) + (v[j][k].z * v[j][k].z + v[j][k].w * v[j][k].w); }
            const float rs = rsqrtf(wave_sum(sq) * (1.f / 1024.f) + 1e-5f);
#pragma unroll
            for (int j = 0; j < 2; ++j)
#pragma unroll
                for (int k = 0; k < 2; ++k) *(f32x4*)(H + (size_t)m * DM + j * 512 + lane * 8 + k * 4) = v[j][k] * rs * gv[j][k];
        }
    }
#ifdef DBG_STOP
    if (lo == 100) {
        const unsigned short* base = (const unsigned short*)(ws + (size_t)DBG_LO * MiB); const size_t n = (size_t)(DBG_HI - DBG_LO) * MiB / 2;
        for (size_t i = (size_t)blockIdx.x * 512 + tid; i < (size_t)MTOK * DM; i += (size_t)G * 512) { float sum = 0.f; for (size_t e = i; e < n; e += (size_t)MTOK * DM) sum += (float)base[e]; args.out[i] = sum; }
    }
#endif
#undef IN
#undef SEAM
}

#ifndef MK_N_LAUNCHES
#define MK_N_LAUNCHES 14
#endif

__global__ void dbg_fill(float* o, size_t n, float v) { for (size_t i = (size_t)blockIdx.x * 256 + threadIdx.x; i < n; i += (size_t)gridDim.x * 256) o[i] = v; }
extern "C" void kernel_launch(void* const* d_in, const int* in_sizes, int n_in, void* d_out, int out_size, void* d_ws, size_t ws_size, hipStream_t stream) {
    static int grid = 0;
    if (grid == 0) {
        if (n_in != 23 || in_sizes[0] != MTOK * DM || out_size != MTOK * DM || ws_size < WS_END) {
            fprintf(stderr, "kernel_launch: unexpected shapes: n_in %d in0 %d out %d ws %zu (need %zu)\n", n_in, n_in > 0 ? in_sizes[0] : -1, out_size, ws_size, (size_t)WS_END); grid = -1; return; }
        int dev = 0, cus = 0, per_cu = 0;
        if (hipGetDevice(&dev) != hipSuccess || hipDeviceGetAttribute(&cus, hipDeviceAttributeMultiprocessorCount, dev) != hipSuccess) { fprintf(stderr, "kernel_launch: device query failed\n"); grid = -1; return; }
        if (hipFuncSetAttribute((const void*)hybrid_fwd, hipFuncAttributeMaxDynamicSharedMemorySize, LDS_BYTES) != hipSuccess) { fprintf(stderr, "kernel_launch: hipFuncSetAttribute failed\n"); grid = -1; return; }
        if (hipOccupancyMaxActiveBlocksPerMultiprocessor(&per_cu, (const void*)hybrid_fwd, 512, LDS_BYTES) != hipSuccess || per_cu < 1) { fprintf(stderr, "kernel_launch: occupancy query says %d\n", per_cu); per_cu = 1; }
        (void)hipGetLastError();
        grid = cus * per_cu;
    }
    if (grid < 0) return;
    if (hipMemsetAsync(d_ws, 0, 16384, stream) != hipSuccess) { fprintf(stderr, "kernel_launch: memset failed\n"); return; }
    Args a{};
    for (int i = 0; i < 23; ++i) a.in[i] = (const float*)d_in[i];
    a.out = (float*)d_out; a.ws = (unsigned char*)d_ws;
#if MK_N_LAUNCHES == 1
    a.ph_lo = 0; a.ph_hi = NPHASE;
    void* kargs[] = {&a};
    hipError_t e = hipLaunchCooperativeKernel((const void*)hybrid_fwd, dim3(grid), dim3(512), kargs, LDS_BYTES, stream);
    if (e != hipSuccess) fprintf(stderr, "kernel_launch: cooperative launch failed: %s (grid %d)\n", hipGetErrorString(e), grid);
#else
#ifdef DBG_STOP
    for (int p = 0; p <= DBG_STOP; ++p) { a.ph_lo = p; a.ph_hi = p + 1; hipLaunchKernelGGL(hybrid_fwd, dim3(grid), dim3(512), LDS_BYTES, stream, a); }
    if (DBG_HI > DBG_LO) { a.ph_lo = 100; a.ph_hi = 101; hipLaunchKernelGGL(hybrid_fwd, dim3(grid), dim3(512), LDS_BYTES, stream, a); }
#else
    for (int p = 0; p < NPHASE; ++p) { a.ph_lo = p; a.ph_hi = p + 1; hipLaunchKernelGGL(hybrid_fwd, dim3(grid), dim3(512), LDS_BYTES, stream, a); }
#endif
#endif
}
```

```cpp
#define MK_N_LAUNCHES 1
#include <hip/hip_runtime.h>
#include <hip/hip_cooperative_groups.h>
#include <cstdio>
#include <cstdint>
namespace cg = cooperative_groups;
namespace pg8 {
#define PG8_LAS __attribute__((address_space(3)))
typedef unsigned short bf16_t;
typedef short bf16x8 __attribute__((ext_vector_type(8)));
typedef float f32x4 __attribute__((ext_vector_type(4)));
typedef unsigned u32x4 __attribute__((ext_vector_type(4)));
constexpr int BM = 256, BK = 64, HALF = 128, HTB = HALF * BK * 2  , STAGE_BYTES = 8 * HTB, NXCD = 8, WGM = 8;

__host__ __device__ __forceinline__ int lds_byte(int r, int c) { const int st = (r >> 4) * 2 + (c >> 5), rr = r & 15, cc = c & 31, ob = rr * 64 + cc * 2; return st * 1024 + (ob ^ (((ob >> 9) & 1) << 5)); }
__host__ __device__ __forceinline__ void stage_rc(int b, int& R, int& C) { const int st = b / 1024, sb = b % 1024, swz = sb ^ (((sb >> 9) & 1) << 5); R = (st >> 1) * 16 + swz / 64; C = (st & 1) * 32 + (swz % 64) / 2; }
__host__ __device__ __forceinline__ int perm32(int rho) { const int n = rho >> 4, i = rho & 15; return 8 * (i >> 2) + 4 * n + (i & 3); }

struct Unit { int pm, pn; };
struct Gemm { const bf16_t* A; const bf16_t* Bt; int M, N, K; int lda; };

struct StaticOrder {
    int nM, nN, nwg, G, c;
    __host__ __device__ void init(int M, int N, int G_, int c_) { nM = M / BM; nN = N / BM; nwg = nM * nN; G = G_; c = c_; }
    __host__ __device__ bool next(int i, Unit& u) const {
        const long L = (long)i * G + c; if (L >= nwg) return false;
        int wgid = (int)L; { const int q = nwg / NXCD, r = nwg % NXCD, xcd = wgid % NXCD, off = wgid / NXCD; wgid = (xcd < r ? xcd * (q + 1) : r * (q + 1) + (xcd - r) * q) + off; }
        const int nig = WGM * nN, gid = wgid / nig, fm = gid * WGM, gsz = (nM - fm) < WGM ? (nM - fm) : WGM;
        u.pm = fm + ((wgid % nig) % gsz); u.pn = (wgid % nig) / gsz; return true;
    }
    __device__ __forceinline__ void a_ready(const Unit&) const {}
    __device__ __forceinline__ void done(const Unit&) const {}
};

__device__ __forceinline__ unsigned cvt_pk_bf16(float lo, float hi) { unsigned r; asm volatile("v_cvt_pk_bf16_f32 %0, %1, %2" : "=v"(r) : "v"(lo), "v"(hi)); return r; }
typedef float f32x2 __attribute__((ext_vector_type(2)));
template <class Epi, class Sched, bool ALIGN_EPI = false, bool SP2 = false>
__device__ __forceinline__ void gemm_phase(PG8_LAS unsigned char* lds, const Gemm g, const Sched& S, const Epi& E) {
    const int tid = threadIdx.x, wid = __builtin_amdgcn_readfirstlane(tid >> 6), lane = tid & 63, wr = wid >> 2, wc = wid & 3, fr = lane & 15, fq = lane >> 4;
    const int K = g.K, nt = K / BK, lda = g.lda ? g.lda : g.K;
    unsigned voffA[2], voffB[2];
#pragma unroll
    for (int i = 0; i < 2; ++i) { int R, C; stage_rc(tid * 16 + i * 8192, R, C); const int Rb = Epi::PERM ? ((R & ~31) + perm32(R & 31)) : R;
        voffA[i] = (unsigned)(R * lda + C) * 2u; voffB[i] = (unsigned)(Rb * K + C) * 2u; }
    const size_t kstep = (size_t)(BK * 2);
    const size_t hstep = (size_t)HALF * K * 2;
    const size_t tstep = 2 * hstep; const size_t hstepA = (size_t)HALF * lda * 2, tstepA = 2 * hstepA;
    const unsigned ldsw = (unsigned)wid * 1024u;
    const int aoff = lds_byte(wr * 64 + fr, fq * 8), boff = lds_byte(wc * 32 + fr, fq * 8);
#define PG8_SA(b, h) (((b) * 2 + (h)) * HTB)
#define PG8_SB(b, h) ((4 + (b) * 2 + (h)) * HTB)
#define PG8_STAGE(bufoff, gbase, voff) do { _Pragma("unroll") for (int _i = 0; _i < 2; ++_i) \
        __builtin_amdgcn_global_load_lds((const unsigned*)((const char*)(gbase) + (voff)[_i]), (PG8_LAS unsigned*)(lds + (bufoff) + ldsw + _i * 8192), 16, 0, 0); } while (0)
#define PG8_LDA(dst, b, h) do { _Pragma("unroll") for (int m = 0; m < 4; ++m) _Pragma("unroll") for (int k = 0; k < 2; ++k) dst[m][k] = *(const PG8_LAS bf16x8*)(lds + PG8_SA(b, h) + aoff + m * 2048 + k * 1024); } while (0)
#define PG8_LDB(dst, b, h) do { _Pragma("unroll") for (int n = 0; n < 2; ++n) _Pragma("unroll") for (int k = 0; k < 2; ++k) dst[n][k] = *(const PG8_LAS bf16x8*)(lds + PG8_SB(b, h) + boff + n * 2048 + k * 1024); } while (0)
#define PG8_MMA(ai, bj, At, Bt) do { __builtin_amdgcn_s_setprio(1); _Pragma("unroll") for (int m = 0; m < 4; ++m) _Pragma("unroll") for (int n = 0; n < 2; ++n) _Pragma("unroll") for (int k = 0; k < 2; ++k) \
        acc[ai][bj][m][n] = __builtin_amdgcn_mfma_f32_16x16x32_bf16(Bt[n][k], At[m][k], acc[ai][bj][m][n], 0, 0, 0); __builtin_amdgcn_s_setprio(0); } while (0)
#define PG8_WAIT_V(n) asm volatile("s_waitcnt vmcnt(" #n ")" ::: "memory")
#define PG8_WAIT_L(n) asm volatile("s_waitcnt lgkmcnt(" #n ")" ::: "memory")
#define PG8_BAR __builtin_amdgcn_s_barrier()
#define PG8_SCHED __builtin_amdgcn_sched_barrier(0)
    Unit cur, nxt; int ui = 0;
    if (!S.next(0, cur)) return;
    f32x4 acc[2][2][4][2];
#pragma unroll
    for (int a = 0; a < 2; ++a)
#pragma unroll
        for (int b = 0; b < 2; ++b)
#pragma unroll
            for (int m = 0; m < 4; ++m)
#pragma unroll
                for (int n = 0; n < 2; ++n) acc[a][b][m][n] = (f32x4){0.f, 0.f, 0.f, 0.f};
    bf16x8 At[4][2], B0[2][2], B1[2][2];
    const char* cA = (const char*)g.A + (size_t)cur.pm * tstepA; const char* cB = (const char*)g.Bt + (size_t)cur.pn * tstep;
    S.a_ready(cur);
    if constexpr (SP2) {
        PG8_STAGE(PG8_SB(0, 0), cB, voffB); PG8_STAGE(PG8_SB(0, 1), cB + hstep, voffB); PG8_STAGE(PG8_SA(0, 0), cA, voffA); PG8_STAGE(PG8_SA(0, 1), cA + hstepA, voffA);
        if (wr == 1) PG8_BAR;
        PG8_WAIT_V(2); PG8_BAR;
        PG8_STAGE(PG8_SB(1, 0), cB + kstep, voffB); PG8_STAGE(PG8_SA(1, 0), cA + kstep, voffA); PG8_STAGE(PG8_SB(1, 1), cB + hstep + kstep, voffB);
        PG8_WAIT_V(6); PG8_BAR;
    } else {
        PG8_STAGE(PG8_SB(0, 0), cB, voffB); PG8_STAGE(PG8_SA(0, 0), cA, voffA); PG8_STAGE(PG8_SB(0, 1), cB + hstep, voffB); PG8_STAGE(PG8_SA(0, 1), cA + hstepA, voffA);
        if (wr == 1) PG8_BAR;
        PG8_WAIT_V(4); PG8_BAR;
        PG8_STAGE(PG8_SB(1, 0), cB + kstep, voffB); PG8_STAGE(PG8_SA(1, 0), cA + kstep, voffA); PG8_STAGE(PG8_SB(1, 1), cB + hstep + kstep, voffB);
        PG8_WAIT_V(6); PG8_BAR;
    }
    for (;;) {
        const bool has_next = S.next(ui + 1, nxt);
        const char* nA = has_next ? (const char*)g.A + (size_t)nxt.pm * tstepA : cA; const char* nB = has_next ? (const char*)g.Bt + (size_t)nxt.pn * tstep : cB;
        for (int t = 0; t < nt; t += 2) {
            const bool last = (t == nt - 2);
            const char* a1 = cA + (size_t)(t + 1) * kstep;
            const char* a2 = last ? nA : cA + (size_t)(t + 2) * kstep; const char* b2 = last ? nB : cB + (size_t)(t + 2) * kstep;
            const char* a3 = a2 + kstep; const char* b3 = b2 + kstep;
            if (last && has_next) S.a_ready(nxt);
            if constexpr (SP2) {
            PG8_LDB(B0, 0, 0); PG8_LDB(B1, 0, 1); PG8_SCHED; PG8_LDA(At, 0, 0); PG8_STAGE(PG8_SA(1, 1), a1 + hstepA, voffA);
            PG8_WAIT_V(8); PG8_WAIT_L(0); PG8_BAR; PG8_MMA(0, 0, At, B0); PG8_MMA(0, 1, At, B1); PG8_BAR; PG8_SCHED;
            PG8_LDA(At, 0, 1); PG8_STAGE(PG8_SB(0, 0), b2, voffB); PG8_STAGE(PG8_SB(0, 1), b2 + hstep, voffB); PG8_STAGE(PG8_SA(0, 0), a2, voffA);
            PG8_WAIT_V(8); PG8_WAIT_L(0); PG8_BAR; PG8_MMA(1, 0, At, B0); PG8_MMA(1, 1, At, B1); PG8_BAR; PG8_SCHED;
            PG8_LDB(B0, 1, 0); PG8_LDB(B1, 1, 1); PG8_SCHED; PG8_LDA(At, 1, 0); PG8_STAGE(PG8_SA(0, 1), a2 + hstepA, voffA);
            PG8_WAIT_V(8); PG8_WAIT_L(0); PG8_BAR; PG8_MMA(0, 0, At, B0); PG8_MMA(0, 1, At, B1); PG8_BAR; PG8_SCHED;
            PG8_LDA(At, 1, 1); PG8_STAGE(PG8_SB(1, 0), b3, voffB); PG8_STAGE(PG8_SB(1, 1), b3 + hstep, voffB); PG8_STAGE(PG8_SA(1, 0), a3, voffA);
            PG8_WAIT_V(8); PG8_WAIT_L(0); PG8_BAR; PG8_MMA(1, 0, At, B0); PG8_MMA(1, 1, At, B1); PG8_BAR; PG8_SCHED;
            } else {
            PG8_LDB(B0, 0, 0); PG8_SCHED; PG8_LDA(At, 0, 0); PG8_STAGE(PG8_SA(1, 1), a1 + hstepA, voffA);
            PG8_WAIT_L(8); PG8_BAR; PG8_WAIT_L(0); PG8_MMA(0, 0, At, B0); PG8_BAR; PG8_SCHED;
            PG8_LDB(B1, 0, 1); PG8_STAGE(PG8_SB(0, 0), b2, voffB);
            PG8_BAR; PG8_WAIT_L(0); PG8_MMA(0, 1, At, B1); PG8_BAR;
            PG8_LDA(At, 0, 1); PG8_STAGE(PG8_SA(0, 0), a2, voffA);
            PG8_BAR; PG8_WAIT_L(0); PG8_MMA(1, 0, At, B0); PG8_BAR; PG8_SCHED;
            PG8_STAGE(PG8_SB(0, 1), b2 + hstep, voffB);
            PG8_WAIT_V(6); PG8_BAR; PG8_MMA(1, 1, At, B1); PG8_BAR;
            PG8_LDB(B0, 1, 0); PG8_SCHED; PG8_LDA(At, 1, 0); PG8_STAGE(PG8_SA(0, 1), a2 + hstepA, voffA);
            PG8_WAIT_L(8); PG8_BAR; PG8_WAIT_L(0); PG8_MMA(0, 0, At, B0); PG8_BAR; PG8_SCHED;
            PG8_LDB(B1, 1, 1); PG8_STAGE(PG8_SB(1, 0), b3, voffB);
            PG8_BAR; PG8_WAIT_L(0); PG8_MMA(0, 1, At, B1); PG8_BAR;
            PG8_LDA(At, 1, 1); PG8_STAGE(PG8_SA(1, 0), a3, voffA);
            PG8_BAR; PG8_WAIT_L(0); PG8_MMA(1, 0, At, B0); PG8_BAR; PG8_SCHED;
            PG8_STAGE(PG8_SB(1, 1), b3 + hstep, voffB);
            PG8_WAIT_V(6); PG8_BAR; PG8_MMA(1, 1, At, B1); PG8_BAR;
            }
        }
        if constexpr (ALIGN_EPI) { if (wr == 0) PG8_BAR; }
        if constexpr (!Epi::AFTER_DRAIN) { E(acc, cur, wr, wc, fr, fq); S.done(cur); }
        if (!has_next) break;
#pragma unroll
        for (int a = 0; a < 2; ++a)
#pragma unroll
            for (int b = 0; b < 2; ++b)
#pragma unroll
                for (int m = 0; m < 4; ++m)
#pragma unroll
                    for (int n = 0; n < 2; ++n) acc[a][b][m][n] = (f32x4){0.f, 0.f, 0.f, 0.f};
        cur = nxt; cA = nA; cB = nB; ++ui;
        if constexpr (ALIGN_EPI) { if (wr == 1) PG8_BAR; }
    }
    PG8_WAIT_V(0);
    if constexpr (!ALIGN_EPI) { if (wr == 0) PG8_BAR; }
    PG8_BAR;
    if constexpr (Epi::AFTER_DRAIN) { E.fused(acc, cur, wr, wc, fr, fq, lds, wid, lane); S.done(cur); }
#undef PG8_SA
#undef PG8_SB
#undef PG8_STAGE
#undef PG8_LDA
#undef PG8_LDB
#undef PG8_MMA
#undef PG8_WAIT_V
#undef PG8_WAIT_L
#undef PG8_BAR
#undef PG8_SCHED
}
}

#define LAS __attribute__((address_space(3)))
typedef unsigned short bf16;
typedef unsigned u32x4 __attribute__((ext_vector_type(4)));
typedef unsigned u32x2 __attribute__((ext_vector_type(2)));
typedef float f32x4 __attribute__((ext_vector_type(4)));
typedef float f32x2 __attribute__((ext_vector_type(2)));
typedef short bf16x8 __attribute__((ext_vector_type(8)));
#define LDS_WAIT() asm volatile("s_waitcnt lgkmcnt(0)" ::: "memory")

constexpr int MTOK = 32768, DM = 1024, DFF = 4096, QKVD = 1280, INEV = 5136, NPROJ = 5120;
constexpr size_t MiB = 1u << 20;
constexpr size_t WS_WGM = 1 * MiB, WS_WIN = 2 * MiB, WS_WOUT = 12 * MiB, WS_WUP0 = 16 * MiB, WS_WUP1 = 24 * MiB, WS_WDN0 = 32 * MiB, WS_WDN1 = 40 * MiB,
                 WS_WQKV = 48 * MiB, WS_WO = 51 * MiB, WS_DT = 53 * MiB, WS_SSP = 55 * MiB, WS_LNP = 57 * MiB, WS_DEC = 61 * MiB, WS_XB = 62 * MiB, WS_ST = 126 * MiB,
                 WS_MIX = 190 * MiB, WS_GV = 318 * MiB, WS_XBC = 382 * MiB, WS_HID = 190 * MiB, WS_QKV = 190 * MiB, WS_ATT = 270 * MiB, WS_END = 510 * MiB;
constexpr int LDS_BYTES = 147456;
constexpr int HIDP = DFF + 64;
constexpr int NPHASE = 14;

typedef __bf16 bf16x2_t __attribute__((ext_vector_type(2)));
__device__ __forceinline__ unsigned pk2(float lo, float hi) { const f32x2 v = {lo, hi}; const bf16x2_t b = __builtin_convertvector(v, bf16x2_t); return __builtin_bit_cast(unsigned, b); }
__device__ __forceinline__ float bflo(unsigned u) { return __uint_as_float(u << 16); }
__device__ __forceinline__ float bfhi(unsigned u) { return __uint_as_float(u & 0xffff0000u); }
__device__ __forceinline__ float ex(float x) { return __builtin_amdgcn_exp2f(x * 1.4426950408889634f); }
__device__ __forceinline__ float rcp(float x) { return __builtin_amdgcn_rcpf(x); }
__device__ __forceinline__ float gelu_t(float x) { const float u = 1.5957691216057308f * (x + 0.044715f * x * x * x); return x * rcp(1.f + ex(-u)); }
__device__ __forceinline__ float silu(float x) { return x * rcp(1.f + ex(-x)); }
__device__ __forceinline__ f32x4 mma(f32x4 acc, bf16x8 a, bf16x8 b) { return __builtin_amdgcn_mfma_f32_16x16x32_bf16(b, a, acc, 0, 0, 0); }
__device__ __forceinline__ bf16x8 lds128(LAS unsigned char* lds, int byteoff) { return *(const LAS bf16x8*)(lds + byteoff); }
__device__ __forceinline__ void st16(LAS unsigned char* lds, int byteoff, unsigned v) { *(LAS unsigned short*)(lds + byteoff) = (unsigned short)v; }

struct Args { const float* in[23]; float* out; unsigned char* ws; int ph_lo, ph_hi; };

__device__ __forceinline__ float row_rstd(const float* ssp, size_t row, int fq) {
    const f32x4 p = *(const f32x4*)(ssp + row * 16 + fq * 4);
    float s = (p.x + p.y) + (p.z + p.w);
    s += __shfl_xor(s, 16); s += __shfl_xor(s, 32);
    return rsqrtf(s * (1.f / 1024.f) + 1e-5f);
}
struct EpiInProj {
    static constexpr bool PERM = true, AFTER_DRAIN = false;
    const float* ssp; bf16* mix; bf16* gv; bf16* xbc; float* lnp;
    __device__ __forceinline__ void operator()(const f32x4 (&acc)[2][2][4][2], const pg8::Unit& u, int wr, int wc, int fr, int fq) const {
        const size_t row0 = (size_t)u.pm * 256 + wr * 64 + fr; const int cl = wc * 32 + 8 * fq; const int pn = u.pn;
        bf16* dst; int ld; bool act = false, stats = false;
        if (pn < 4) { dst = mix + pn * 256; ld = 2048; act = true; }
        else if (pn < 8) { dst = gv + (pn - 4) * 256; ld = 1024; act = true; stats = true; }
        else if (pn < 12) { dst = mix + 1024 + (pn - 8) * 256; ld = 2048; }
        else { dst = xbc + (pn - 12) * 256; ld = 2048; }
#pragma unroll
        for (int ai = 0; ai < 2; ++ai)
#pragma unroll
            for (int m = 0; m < 4; ++m) {
                const size_t row = row0 + ai * 128 + m * 16; const float rs = row_rstd(ssp, row, fq);
                float s1 = 0.f, s2 = 0.f;
#pragma unroll
                for (int bj = 0; bj < 2; ++bj) {
                    f32x4 v0 = acc[ai][bj][m][0] * rs, v1 = acc[ai][bj][m][1] * rs;
                    if (act) {
#pragma unroll
                        for (int j = 0; j < 4; ++j) { v0[j] = gelu_t(v0[j]); v1[j] = gelu_t(v1[j]); }
                    }
                    if (stats) {
#pragma unroll
                        for (int j = 0; j < 4; ++j) { s1 += v0[j] + v1[j]; s2 += v0[j] * v0[j] + v1[j] * v1[j]; }
                    }
                    u32x4 w; w.x = pk2(v0[0], v0[1]); w.y = pk2(v0[2], v0[3]); w.z = pk2(v1[0], v1[1]); w.w = pk2(v1[2], v1[3]);
                    *(u32x4*)(dst + row * ld + bj * 128 + cl) = w;
                }
                if (stats) {
                    s1 += __shfl_xor(s1, 16); s1 += __shfl_xor(s1, 32); s2 += __shfl_xor(s2, 16); s2 += __shfl_xor(s2, 32);
                    if (fq == 0) { f32x2 o; o.x = s1; o.y = s2; *(f32x2*)(lnp + (row * 16 + (pn - 4) * 4 + wc) * 2) = o; }
                }
            }
    }
};
struct EpiResid {
    static constexpr bool PERM = true, AFTER_DRAIN = false;
    bf16* xb; float* ssp; const float* bias;
    __device__ __forceinline__ void operator()(const f32x4 (&acc)[2][2][4][2], const pg8::Unit& u, int wr, int wc, int fr, int fq) const {
        const size_t row0 = (size_t)u.pm * 256 + wr * 64 + fr; const int col0 = u.pn * 256 + wc * 32 + 8 * fq;
        f32x4 bv[2][2];
#pragma unroll
        for (int bj = 0; bj < 2; ++bj)
#pragma unroll
            for (int n = 0; n < 2; ++n) bv[bj][n] = bias ? *(const f32x4*)(bias + col0 + bj * 128 + 4 * n) : (f32x4){0.f, 0.f, 0.f, 0.f};
#pragma unroll
        for (int ai = 0; ai < 2; ++ai)
#pragma unroll
            for (int m = 0; m < 4; ++m) {
                const size_t row = row0 + ai * 128 + m * 16; float ss = 0.f;
#pragma unroll
                for (int bj = 0; bj < 2; ++bj) {
                    const size_t off = row * 1024 + col0 + bj * 128;
                    const u32x4 rv = *(const u32x4*)(xb + off);
                    f32x4 v0 = acc[ai][bj][m][0] + bv[bj][0], v1 = acc[ai][bj][m][1] + bv[bj][1];
                    v0[0] += bflo(rv.x); v0[1] += bfhi(rv.x); v0[2] += bflo(rv.y); v0[3] += bfhi(rv.y); v1[0] += bflo(rv.z); v1[1] += bfhi(rv.z); v1[2] += bflo(rv.w); v1[3] += bfhi(rv.w);
#pragma unroll
                    for (int j = 0; j < 4; ++j) ss += v0[j] * v0[j] + v1[j] * v1[j];
                    u32x4 w; w.x = pk2(v0[0], v0[1]); w.y = pk2(v0[2], v0[3]); w.z = pk2(v1[0], v1[1]); w.w = pk2(v1[2], v1[3]);
                    *(u32x4*)(xb + off) = w;
                }
                ss += __shfl_xor(ss, 16); ss += __shfl_xor(ss, 32);
                if (fq == 0) ssp[row * 16 + u.pn * 4 + wc] = ss;
            }
    }
};
struct EpiRelu2 {
    static constexpr bool PERM = true, AFTER_DRAIN = false;
    const float* ssp; bf16* hid;
    __device__ __forceinline__ void operator()(const f32x4 (&acc)[2][2][4][2], const pg8::Unit& u, int wr, int wc, int fr, int fq) const {
        const size_t row0 = (size_t)u.pm * 256 + wr * 64 + fr; const int col0 = u.pn * 256 + wc * 32 + 8 * fq;
#pragma unroll
        for (int ai = 0; ai < 2; ++ai)
#pragma unroll
            for (int m = 0; m < 4; ++m) {
                const size_t row = row0 + ai * 128 + m * 16; const float rs = row_rstd(ssp, row, fq);
#pragma unroll
                for (int bj = 0; bj < 2; ++bj) {
                    f32x4 v0 = acc[ai][bj][m][0] * rs, v1 = acc[ai][bj][m][1] * rs;
#pragma unroll
                    for (int j = 0; j < 4; ++j) { const float a = fmaxf(v0[j], 0.f), b = fmaxf(v1[j], 0.f); v0[j] = a * a; v1[j] = b * b; }
                    u32x4 w; w.x = pk2(v0[0], v0[1]); w.y = pk2(v0[2], v0[3]); w.z = pk2(v1[0], v1[1]); w.w = pk2(v1[2], v1[3]);
                    *(u32x4*)(hid + row * HIDP + col0 + bj * 128) = w;
                }
            }
    }
};
struct EpiQKV {
    static constexpr bool PERM = true, AFTER_DRAIN = false;
    const float* ssp; bf16* o; const float* bias;
    __device__ __forceinline__ void operator()(const f32x4 (&acc)[2][2][4][2], const pg8::Unit& u, int wr, int wc, int fr, int fq) const {
        const size_t row0 = (size_t)u.pm * 256 + wr * 64 + fr; const int col0 = u.pn * 256 + wc * 32 + 8 * fq;
        f32x4 bv[2][2];
#pragma unroll
        for (int bj = 0; bj < 2; ++bj)
#pragma unroll
            for (int n = 0; n < 2; ++n) bv[bj][n] = *(const f32x4*)(bias + col0 + bj * 128 + 4 * n);
#pragma unroll
        for (int ai = 0; ai < 2; ++ai)
#pragma unroll
            for (int m = 0; m < 4; ++m) {
                const size_t row = row0 + ai * 128 + m * 16; const float rs = row_rstd(ssp, row, fq);
#pragma unroll
                for (int bj = 0; bj < 2; ++bj) {
                    const f32x4 v0 = acc[ai][bj][m][0] * rs + bv[bj][0], v1 = acc[ai][bj][m][1] * rs + bv[bj][1];
                    u32x4 w; w.x = pk2(v0[0], v0[1]); w.y = pk2(v0[2], v0[3]); w.z = pk2(v1[0], v1[1]); w.w = pk2(v1[2], v1[3]);
                    *(u32x4*)(o + row * QKVD + col0 + bj * 128) = w;
                }
            }
    }
};

__device__ __forceinline__ void p0_transpose_item(const float* __restrict__ W, int ldw, int K, int nblk, bf16* WT, const float* __restrict__ gain, LAS float* scr, int item, int lane) {
    const int kb = item / nblk, nb = item % nblk, k0 = 64 * kb, n0 = 32 * nb;
#pragma unroll
    for (int i = 0; i < 8; ++i) {
        const int kk = 8 * i + (lane >> 3), c4 = (lane & 7) * 4; const float gs = gain ? gain[k0 + kk] : 1.f;
        const f32x4 v = *(const f32x4*)(W + (size_t)(k0 + kk) * ldw + n0 + c4);
        scr[kk * 33 + c4] = v.x * gs; scr[kk * 33 + c4 + 1] = v.y * gs; scr[kk * 33 + c4 + 2] = v.z * gs; scr[kk * 33 + c4 + 3] = v.w * gs;
    }
    LDS_WAIT(); asm volatile("" ::: "memory");
    const int c = lane & 7;
#pragma unroll
    for (int j = 0; j < 4; ++j) { const int n = (lane >> 3) + 8 * j; const LAS float* s = scr + (8 * c) * 33 + n;
        u32x4 o; o.x = pk2(s[0 * 33], s[1 * 33]); o.y = pk2(s[2 * 33], s[3 * 33]); o.z = pk2(s[4 * 33], s[5 * 33]); o.w = pk2(s[6 * 33], s[7 * 33]);
        *(u32x4*)(WT + (size_t)(n0 + n) * K + k0 + 8 * c) = o; }
    LDS_WAIT(); asm volatile("" ::: "memory");
}

__device__ __forceinline__ void phase0(const Args& a, LAS unsigned char* lds, int tid, int lane, int wave, int G) {
    const float* x = a.in[0]; const float* g_mix = a.in[1]; const float* g_mlp = a.in[2]; const float* w_in = a.in[4]; const float* w_out = a.in[5];
    const float* gm_w = a.in[8]; const float* dt_bias = a.in[12]; const float* w_qkv = a.in[16]; const float* w_o = a.in[18]; const float* w_up = a.in[21]; const float* w_dn = a.in[22];
    unsigned char* ws = a.ws;
    bf16* XB = (bf16*)(ws + WS_XB); float* DT = (float*)(ws + WS_DT); float* SSP = (float*)(ws + WS_SSP);
    for (int idx = tid; idx < 16384; idx += 512) { const int k = idx >> 4, j = idx & 15; const float v = w_in[(size_t)k * INEV + NPROJ + j] * g_mix[k]; st16(lds, (j * 1032 + k) * 2, pk2(v, v)); }
    __syncthreads();
    const int gw = blockIdx.x * 8 + wave, NGW = G * 8;
    for (int item = gw; item < MTOK / 16; item += NGW) {
        const int r = lane & 15, q = lane >> 4; const size_t row = (size_t)item * 16 + r;
        const float* xp = x + row * DM + q * 8; bf16* xo = XB + row * DM + q * 8;
        f32x4 acc = {0.f, 0.f, 0.f, 0.f}; float ss = 0.f;
#pragma unroll 8
        for (int kk = 0; kk < 32; ++kk) {
            const f32x4 v0 = *(const f32x4*)(xp + kk * 32), v1 = *(const f32x4*)(xp + kk * 32 + 4);
            ss += (v0.x * v0.x + v0.y * v0.y) + (v0.z * v0.z + v0.w * v0.w) + (v1.x * v1.x + v1.y * v1.y) + (v1.z * v1.z + v1.w * v1.w);
            u32x4 w; w.x = pk2(v0.x, v0.y); w.y = pk2(v0.z, v0.w); w.z = pk2(v1.x, v1.y); w.w = pk2(v1.z, v1.w);
            *(u32x4*)(xo + kk * 32) = w;
            const bf16x8 bfr = lds128(lds, (r * 1032 + kk * 32 + q * 8) * 2);
            acc = mma(acc, __builtin_bit_cast(bf16x8, w), bfr);
        }
        ss += __shfl_xor(ss, 16); ss += __shfl_xor(ss, 32);
        const float rstd = rsqrtf(ss * (1.f / 1024.f) + 1e-5f);
        const f32x4 bias = *(const f32x4*)(dt_bias + q * 4);
        f32x4 o;
#pragma unroll
        for (int j = 0; j < 4; ++j) { const float v = acc[j] * rstd + bias[j]; o[j] = v > 20.f ? v : log1pf(expf(v)); }
        *(f32x4*)(DT + row * 16 + q * 4) = o;
        f32x4 sp = {q == 0 ? ss : 0.f, 0.f, 0.f, 0.f};
        *(f32x4*)(SSP + row * 16 + q * 4) = sp;
    }
    __syncthreads();
    LAS float* scr = (LAS float*)(lds + wave * 16384);
    constexpr int I_IN = 16 * 160, I_OUT = 32 * 32, I_UP = 16 * 128, I_DN = 64 * 32, I_QKV = 16 * 40, I_O = 16 * 32;
    constexpr int NITEMS = I_IN + I_OUT + 2 * I_UP + 2 * I_DN + I_QKV + I_O;
    for (int it = gw; it < NITEMS; it += NGW) {
        int r = it;
        if (r < I_IN) { p0_transpose_item(w_in, INEV, 1024, 160, (bf16*)(ws + WS_WIN), g_mix, scr, r, lane); continue; } r -= I_IN;
        if (r < I_OUT) { p0_transpose_item(w_out, 1024, 2048, 32, (bf16*)(ws + WS_WOUT), nullptr, scr, r, lane); continue; } r -= I_OUT;
        if (r < I_UP) { p0_transpose_item(w_up, 4096, 1024, 128, (bf16*)(ws + WS_WUP0), g_mlp, scr, r, lane); continue; } r -= I_UP;
        if (r < I_UP) { p0_transpose_item(w_up + (size_t)1024 * 4096, 4096, 1024, 128, (bf16*)(ws + WS_WUP1), g_mlp + 1024, scr, r, lane); continue; } r -= I_UP;
        if (r < I_DN) { p0_transpose_item(w_dn, 1024, 4096, 32, (bf16*)(ws + WS_WDN0), nullptr, scr, r, lane); continue; } r -= I_DN;
        if (r < I_DN) { p0_transpose_item(w_dn + (size_t)4096 * 1024, 1024, 4096, 32, (bf16*)(ws + WS_WDN1), nullptr, scr, r, lane); continue; } r -= I_DN;
        if (r < I_QKV) { p0_transpose_item(w_qkv, 1280, 1024, 40, (bf16*)(ws + WS_WQKV), g_mix + 1024, scr, r, lane); continue; } r -= I_QKV;
        p0_transpose_item(w_o, 1024, 1024, 32, (bf16*)(ws + WS_WO), nullptr, scr, r, lane);
    }
    bf16* WGM = (bf16*)(ws + WS_WGM);
    for (int idx = blockIdx.x * 512 + tid; idx < 8 * 128 * 128; idx += G * 512) { const int t = (idx >> 7) & 127, s = idx & 127; const float v = (s <= t) ? gm_w[idx] : 0.f; WGM[idx] = (bf16)(pk2(v, v) & 0xffffu); }
}

__device__ __forceinline__ void conv8(const bf16* __restrict__ XBC, size_t grow0, int l, bool first, int col, const float* __restrict__ cw, const float* __restrict__ cb, float (&o)[8]) {
    const f32x4 b0 = *(const f32x4*)(cb + col), b1 = *(const f32x4*)(cb + col + 4);
    o[0] = b0.x; o[1] = b0.y; o[2] = b0.z; o[3] = b0.w; o[4] = b1.x; o[5] = b1.y; o[6] = b1.z; o[7] = b1.w;
#pragma unroll
    for (int tap = 0; tap < 4; ++tap) {
        const int t = l - 3 + tap;
        u32x4 v = {0u, 0u, 0u, 0u};
        if (!first || t >= 0) v = *(const u32x4*)(XBC + (size_t)((long)grow0 + t) * 2048 + col);
        const f32x4 w0 = *(const f32x4*)(cw + tap * 2048 + col), w1 = *(const f32x4*)(cw + tap * 2048 + col + 4);
        o[0] += w0.x * bflo(v.x); o[1] += w0.y * bfhi(v.x); o[2] += w0.z * bflo(v.y); o[3] += w0.w * bfhi(v.y);
        o[4] += w1.x * bflo(v.z); o[5] += w1.y * bfhi(v.z); o[6] += w1.z * bflo(v.w); o[7] += w1.w * bfhi(v.w);
    }
#pragma unroll
    for (int e = 0; e < 8; ++e) o[e] = silu(o[e]);
}
__device__ __forceinline__ void conv8x8(const bf16* __restrict__ XBC, size_t grow0, int l0, bool first, int col, const float* __restrict__ cw, const float* __restrict__ cb, float (&o)[8][8]) {
    float w[4][8];
#pragma unroll
    for (int tap = 0; tap < 4; ++tap) { const f32x4 w0 = *(const f32x4*)(cw + tap * 2048 + col), w1 = *(const f32x4*)(cw + tap * 2048 + col + 4);
        w[tap][0] = w0.x; w[tap][1] = w0.y; w[tap][2] = w0.z; w[tap][3] = w0.w; w[tap][4] = w1.x; w[tap][5] = w1.y; w[tap][6] = w1.z; w[tap][7] = w1.w; }
    { const f32x4 b0 = *(const f32x4*)(cb + col), b1 = *(const f32x4*)(cb + col + 4);
#pragma unroll
      for (int j = 0; j < 8; ++j) { o[j][0] = b0.x; o[j][1] = b0.y; o[j][2] = b0.z; o[j][3] = b0.w; o[j][4] = b1.x; o[j][5] = b1.y; o[j][6] = b1.z; o[j][7] = b1.w; } }
#pragma unroll
    for (int rr = 0; rr < 11; ++rr) {
        const int t = l0 - 3 + rr;
        u32x4 v = {0u, 0u, 0u, 0u};
        if (!first || t >= 0) v = *(const u32x4*)(XBC + (size_t)((long)grow0 + t) * 2048 + col);
        float x[8];
        x[0] = bflo(v.x); x[1] = bfhi(v.x); x[2] = bflo(v.y); x[3] = bfhi(v.y); x[4] = bflo(v.z); x[5] = bfhi(v.z); x[6] = bflo(v.w); x[7] = bfhi(v.w);
#pragma unroll
        for (int tap = 0; tap < 4; ++tap) { const int j = rr - tap; if (j >= 0 && j < 8) {
#pragma unroll
            for (int e = 0; e < 8; ++e) o[j][e] += w[tap][e] * x[e]; } }
    }
#pragma unroll
    for (int j = 0; j < 8; ++j)
#pragma unroll
        for (int e = 0; e < 8; ++e) o[j][e] = silu(o[j][e]);
}
__device__ __forceinline__ float ssd_scan(const float* __restrict__ DT, const float* __restrict__ a_log, size_t grow0, int h, int r, int lane, LAS float* acum, LAS float* dts, float& a0o, float& a1o, float& d0o, float& d1o) {
    const float A = -expf(a_log[h]);
    const float d0 = DT[(grow0 + 2 * lane) * 16 + h], d1 = DT[(grow0 + 2 * lane + 1) * 16 + h];
    const float v0 = d0 * A, v1 = d1 * A, s = v0 + v1;
    float inc = s;
#pragma unroll
    for (int o = 1; o < 64; o <<= 1) { const float t = __shfl_up(inc, o); if (lane >= o) inc += t; }
    const float exc = inc - s, a0 = exc + v0, a1 = exc + s;
    acum[r * 128 + 2 * lane] = a0; acum[r * 128 + 2 * lane + 1] = a1; dts[r * 128 + 2 * lane] = d0; dts[r * 128 + 2 * lane + 1] = d1;
    a0o = a0; a1o = a1; d0o = d0; d1o = d1;
    return __shfl(a1, 63);
}

__device__ __forceinline__ void ssd_a_tile(const Args& a, LAS unsigned char* lds, int tile, int tid, int lane, int wave) {
    { int tz; asm volatile("v_mov_b32 %0, 0" : "=v"(tz)); tid += tz; lane += tz; }
    constexpr int XST = 0, BT = 69632, ACUM = 104448, DTS = ACUM + 2048, TOE = DTS + 2048;
    const int g = tile & 3, bc = tile >> 2, c = bc & 31; const size_t grow0 = (size_t)bc * 128;
    unsigned char* ws = a.ws; const bf16* XBC = (const bf16*)(ws + WS_XBC); const float* DT = (const float*)(ws + WS_DT); float* DEC = (float*)(ws + WS_DEC); bf16* ST = (bf16*)(ws + WS_ST);
    const float* cw = a.in[10]; const float* cb = a.in[11]; const float* a_log = a.in[13];
    if (wave < 4) {
        float a0, a1, d0, d1; const float tot = ssd_scan(DT, a_log, grow0, g * 4 + wave, wave, lane, (LAS float*)(lds + ACUM), (LAS float*)(lds + DTS), a0, a1, d0, d1);
        LAS float* toe = (LAS float*)(lds + TOE);
        toe[wave * 128 + 2 * lane] = ex(tot - a0) * d0; toe[wave * 128 + 2 * lane + 1] = ex(tot - a1) * d1;
        if (lane == 0) DEC[bc * 16 + g * 4 + wave] = ex(tot);
    }
    __syncthreads();
    {
        const bool first = (c == 0);
        float o[8][8];
        {
            const int chg = tid & 31, l0 = (tid >> 5) * 8;
            conv8x8(XBC, grow0, l0, first, g * 256 + chg * 8, cw, cb, o);
            const LAS float* toe = (const LAS float*)(lds + TOE) + (chg >> 3) * 128 + l0;
            const f32x4 t0 = *(const LAS f32x4*)toe, t1 = *(const LAS f32x4*)(toe + 4);
#pragma unroll
            for (int e = 0; e < 8; ++e) {
                u32x4 w; w.x = pk2(o[0][e] * t0.x, o[1][e] * t0.y); w.y = pk2(o[2][e] * t0.z, o[3][e] * t0.w); w.z = pk2(o[4][e] * t1.x, o[5][e] * t1.y); w.w = pk2(o[6][e] * t1.z, o[7][e] * t1.w);
                *(LAS u32x4*)(lds + XST + ((chg * 8 + e) * 136 + l0) * 2) = w;
            }
        }
        if (tid < 256) {
            const int chg = tid & 15, l0 = (tid >> 4) * 8;
            conv8x8(XBC, grow0, l0, first, 1024 + g * 128 + chg * 8, cw, cb, o);
#pragma unroll
            for (int e = 0; e < 8; ++e) {
                u32x4 w; w.x = pk2(o[0][e], o[1][e]); w.y = pk2(o[2][e], o[3][e]); w.z = pk2(o[4][e], o[5][e]); w.w = pk2(o[6][e], o[7][e]);
                *(LAS u32x4*)(lds + BT + ((chg * 8 + e) * 136 + l0) * 2) = w;
            }
        }
    }
    __syncthreads();
    {
        const int r = wave >> 1, ph = wave & 1, lr = lane & 15, q = lane >> 4;
        f32x4 acc[2][8];
#pragma unroll
        for (int mt = 0; mt < 2; ++mt)
#pragma unroll
            for (int nt = 0; nt < 8; ++nt) acc[mt][nt] = (f32x4){0.f, 0.f, 0.f, 0.f};
#pragma unroll
        for (int ks = 0; ks < 4; ++ks) {
            bf16x8 af[2];
#pragma unroll
            for (int mt = 0; mt < 2; ++mt) af[mt] = lds128(lds, XST + ((r * 64 + ph * 32 + mt * 16 + lr) * 136 + ks * 32 + q * 8) * 2);
#pragma unroll
            for (int nt = 0; nt < 8; ++nt) {
                const bf16x8 bfr = lds128(lds, BT + ((nt * 16 + lr) * 136 + ks * 32 + q * 8) * 2);
#pragma unroll
                for (int mt = 0; mt < 2; ++mt) acc[mt][nt] = mma(acc[mt][nt], af[mt], bfr);
            }
        }
        bf16* stp = ST + ((size_t)bc * 16 + g * 4 + r) * 8192;
#pragma unroll
        for (int mt = 0; mt < 2; ++mt)
#pragma unroll
            for (int nt = 0; nt < 8; ++nt) {
                const int p = ph * 32 + mt * 16 + lr, n = nt * 16 + q * 4;
                u32x2 w; w.x = pk2(acc[mt][nt][0], acc[mt][nt][1]); w.y = pk2(acc[mt][nt][2], acc[mt][nt][3]);
                *(u32x2*)(stp + p * 128 + n) = w;
            }
    }
    __syncthreads();
}

__device__ __forceinline__ void gmlp_tile(const Args& a, LAS unsigned char* lds, int tile, int tid, int lane, int wave) {
    constexpr int VNT = 0;
    const int g = tile & 7, bc = tile >> 3; const size_t grow0 = (size_t)bc * 128;
    unsigned char* ws = a.ws; const bf16* GV = (const bf16*)(ws + WS_GV); const float* LNP = (const float*)(ws + WS_LNP); bf16* MIX = (bf16*)(ws + WS_MIX); const bf16* WGM = (const bf16*)(ws + WS_WGM);
    const float* ln_g = a.in[6]; const float* ln_b = a.in[7]; const float* b_s = a.in[9];
    {
        const int srow = tid >> 2, part = tid & 3; const size_t row = grow0 + srow;
        const f32x4 p0 = *(const f32x4*)(LNP + row * 32 + part * 8), p1 = *(const f32x4*)(LNP + row * 32 + part * 8 + 4);
        float s1 = (p0.x + p0.z) + (p1.x + p1.z), s2 = (p0.y + p0.w) + (p1.y + p1.w);
        s1 += __shfl_xor(s1, 1); s1 += __shfl_xor(s1, 2); s2 += __shfl_xor(s2, 1); s2 += __shfl_xor(s2, 2);
        const float mean = s1 * (1.f / 1024.f), var = s2 * (1.f / 1024.f) - mean * mean, rstd = rsqrtf(var + 1e-5f);
        if (part == 0) { f32x2 ms; ms.x = mean; ms.y = rstd; *(LAS f32x2*)(lds + 34816 + srow * 8) = ms; }
    }
    __syncthreads();
    {
        const int chg = tid & 15, s0 = (tid >> 4) * 4, ch = g * 128 + chg * 8;
        const f32x4 g0 = *(const f32x4*)(ln_g + ch), g1 = *(const f32x4*)(ln_g + ch + 4), c0 = *(const f32x4*)(ln_b + ch), c1 = *(const f32x4*)(ln_b + ch + 4);
        float val[4][8];
#pragma unroll
        for (int jj = 0; jj < 4; ++jj) {
            const u32x4 v = *(const u32x4*)(GV + (grow0 + s0 + jj) * 1024 + ch);
            const f32x2 ms = *(const LAS f32x2*)(lds + 34816 + (s0 + jj) * 8);
            const float mean = ms.x, rstd = ms.y;
            val[jj][0] = (bflo(v.x) - mean) * rstd * g0.x + c0.x; val[jj][1] = (bfhi(v.x) - mean) * rstd * g0.y + c0.y; val[jj][2] = (bflo(v.y) - mean) * rstd * g0.z + c0.z; val[jj][3] = (bfhi(v.y) - mean) * rstd * g0.w + c0.w;
            val[jj][4] = (bflo(v.z) - mean) * rstd * g1.x + c1.x; val[jj][5] = (bfhi(v.z) - mean) * rstd * g1.y + c1.y; val[jj][6] = (bflo(v.w) - mean) * rstd * g1.z + c1.z; val[jj][7] = (bfhi(v.w) - mean) * rstd * g1.w + c1.w;
        }
#pragma unroll
        for (int e = 0; e < 8; ++e) { u32x2 w; w.x = pk2(val[0][e], val[1][e]); w.y = pk2(val[2][e], val[3][e]); *(LAS u32x2*)(lds + VNT + ((chg * 8 + e) * 136 + s0) * 2) = w; }
    }
    __syncthreads();
    {
        const int wr = wave >> 1, wc = wave & 1, lr = lane & 15, q = lane >> 4;
        f32x4 acc[2][4];
#pragma unroll
        for (int mt = 0; mt < 2; ++mt)
#pragma unroll
            for (int nt = 0; nt < 4; ++nt) acc[mt][nt] = (f32x4){0.f, 0.f, 0.f, 0.f};
        for (int ks = 0; ks <= wr; ++ks) {
            bf16x8 af[2];
#pragma unroll
            for (int mt = 0; mt < 2; ++mt) af[mt] = *(const bf16x8*)(WGM + g * 16384 + (wr * 32 + mt * 16 + lr) * 128 + ks * 32 + q * 8);
#pragma unroll
            for (int nt = 0; nt < 4; ++nt) {
                const bf16x8 bfr = lds128(lds, VNT + ((wc * 64 + nt * 16 + lr) * 136 + ks * 32 + q * 8) * 2);
#pragma unroll
                for (int mt = 0; mt < 2; ++mt) acc[mt][nt] = mma(acc[mt][nt], af[mt], bfr);
            }
        }
#pragma unroll
        for (int mt = 0; mt < 2; ++mt) {
            const int t = wr * 32 + mt * 16 + lr; const float bias = b_s[g * 128 + t];
#pragma unroll
            for (int nt = 0; nt < 4; ++nt) {
                bf16* p = MIX + (grow0 + t) * 2048 + g * 128 + wc * 64 + nt * 16 + q * 4;
                const u32x2 uu = *(const u32x2*)p;
                u32x2 w; w.x = pk2((acc[mt][nt][0] + bias) * bflo(uu.x), (acc[mt][nt][1] + bias) * bfhi(uu.x)); w.y = pk2((acc[mt][nt][2] + bias) * bflo(uu.y), (acc[mt][nt][3] + bias) * bfhi(uu.y));
                *(u32x2*)p = w;
            }
        }
    }
    __syncthreads();
}

__device__ __forceinline__ void scan_phase(const Args& a, int tid, int G) {
    bf16* ST = (bf16*)(a.ws + WS_ST); const float* DEC = (const float*)(a.ws + WS_DEC);
    for (int idx = blockIdx.x * 512 + tid; idx < 131072; idx += G * 512) {
        const int pn8 = idx & 1023, h = (idx >> 10) & 15, b = idx >> 14;
        float st[8];
#pragma unroll
        for (int e = 0; e < 8; ++e) st[e] = 0.f;
#pragma unroll 1
        for (int c0 = 0; c0 < 32; c0 += 8) {
            u32x4 v[8]; float dec[8];
#pragma unroll
            for (int cc = 0; cc < 8; ++cc) { const size_t bch = ((size_t)(b * 32 + c0 + cc)) * 16 + h; v[cc] = *(const u32x4*)(ST + bch * 8192 + pn8 * 8); dec[cc] = DEC[bch]; }
#pragma unroll
            for (int cc = 0; cc < 8; ++cc) {
                const size_t bch = ((size_t)(b * 32 + c0 + cc)) * 16 + h;
                u32x4 w; w.x = pk2(st[0], st[1]); w.y = pk2(st[2], st[3]); w.z = pk2(st[4], st[5]); w.w = pk2(st[6], st[7]);
                *(u32x4*)(ST + bch * 8192 + pn8 * 8) = w;
                const float d = dec[cc];
                st[0] = d * st[0] + bflo(v[cc].x); st[1] = d * st[1] + bfhi(v[cc].x); st[2] = d * st[2] + bflo(v[cc].y); st[3] = d * st[3] + bfhi(v[cc].y);
                st[4] = d * st[4] + bflo(v[cc].z); st[5] = d * st[5] + bfhi(v[cc].z); st[6] = d * st[6] + bflo(v[cc].w); st[7] = d * st[7] + bfhi(v[cc].w);
            }
        }
    }
}

__device__ __forceinline__ void ssd_b_tile(const Args& a, LAS unsigned char* lds, int tile, int tid, int lane, int wave) {
    { int tz; asm volatile("v_mov_b32 %0, 0" : "=v"(tz)); tid += tz; lane += tz; }
    constexpr int XST = 0, CM = 69632, BM = 104448, ACUM = 139264, DTS = ACUM + 2048, PSS = DTS + 2048;
    const int g = tile & 3, bc = tile >> 2, c = bc & 31; const size_t grow0 = (size_t)bc * 128;
    unsigned char* ws = a.ws; const bf16* XBC = (const bf16*)(ws + WS_XBC); const float* DT = (const float*)(ws + WS_DT); const bf16* ST = (const bf16*)(ws + WS_ST); bf16* MIX = (bf16*)(ws + WS_MIX);
    const float* cw = a.in[10]; const float* cb = a.in[11]; const float* a_log = a.in[13]; const float* d_skip = a.in[14]; const float* norm_g = a.in[15];
    if (wave < 4) { float a0, a1, d0, d1; (void)ssd_scan(DT, a_log, grow0, g * 4 + wave, wave, lane, (LAS float*)(lds + ACUM), (LAS float*)(lds + DTS), a0, a1, d0, d1); }
    {
        const bool first = (c == 0);
        float o[8][8];
        {
            const int chg = tid & 31, l0 = (tid >> 5) * 8;
            conv8x8(XBC, grow0, l0, first, g * 256 + chg * 8, cw, cb, o);
#pragma unroll
            for (int e = 0; e < 8; ++e) {
                u32x4 w; w.x = pk2(o[0][e], o[1][e]); w.y = pk2(o[2][e], o[3][e]); w.z = pk2(o[4][e], o[5][e]); w.w = pk2(o[6][e], o[7][e]);
                *(LAS u32x4*)(lds + XST + ((chg * 8 + e) * 136 + l0) * 2) = w;
            }
        }
        {
            const int half = tid >> 8, chg = tid & 15, l0 = ((tid >> 4) & 15) * 8;
            conv8x8(XBC, grow0, l0, first, (half ? 1536 : 1024) + g * 128 + chg * 8, cw, cb, o);
            const int dstb = half ? CM : BM;
#pragma unroll
            for (int j = 0; j < 8; ++j) {
                u32x4 w; w.x = pk2(o[j][0], o[j][1]); w.y = pk2(o[j][2], o[j][3]); w.z = pk2(o[j][4], o[j][5]); w.w = pk2(o[j][6], o[j][7]);
                *(LAS u32x4*)(lds + dstb + ((l0 + j) * 136 + chg * 8) * 2) = w;
            }
        }
    }
    __syncthreads();
    const int lr = lane & 15, q = lane >> 4;
    const int r = wave >> 1, lh = wave & 1, h = g * 4 + r;
    bf16x8 pv[4][4];
    {
        const bf16* prev = ST + ((size_t)bc * 16 + h) * 8192;
#pragma unroll
        for (int ks = 0; ks < 4; ++ks)
#pragma unroll
            for (int nt = 0; nt < 4; ++nt) pv[ks][nt] = *(const bf16x8*)(prev + (nt * 16 + lr) * 128 + ks * 32 + q * 8);
    }
    {
        const int wr4 = wave >> 1, wc2 = wave & 1;
        f32x4 cbv[2][4];
#pragma unroll
        for (int mt = 0; mt < 2; ++mt)
#pragma unroll
            for (int nt = 0; nt < 4; ++nt) cbv[mt][nt] = (f32x4){0.f, 0.f, 0.f, 0.f};
#pragma unroll
        for (int ks = 0; ks < 4; ++ks) {
            bf16x8 af[2];
#pragma unroll
            for (int mt = 0; mt < 2; ++mt) af[mt] = lds128(lds, CM + ((wr4 * 32 + mt * 16 + lr) * 136 + ks * 32 + q * 8) * 2);
#pragma unroll
            for (int nt = 0; nt < 4; ++nt) {
                const bf16x8 bfr = lds128(lds, BM + ((wc2 * 64 + nt * 16 + lr) * 136 + ks * 32 + q * 8) * 2);
#pragma unroll
                for (int mt = 0; mt < 2; ++mt) cbv[mt][nt] = mma(cbv[mt][nt], af[mt], bfr);
            }
        }
        __syncthreads();
#pragma unroll
        for (int mt = 0; mt < 2; ++mt)
#pragma unroll
            for (int nt = 0; nt < 4; ++nt) {
                u32x2 w; w.x = pk2(cbv[mt][nt][0], cbv[mt][nt][1]); w.y = pk2(cbv[mt][nt][2], cbv[mt][nt][3]);
                *(LAS u32x2*)(lds + BM + ((wr4 * 32 + mt * 16 + lr) * 136 + wc2 * 64 + nt * 16 + q * 4) * 2) = w;
            }
        __syncthreads();
    }
    const LAS float* acum = (const LAS float*)(lds + ACUM) + r * 128; const LAS float* dts = (const LAS float*)(lds + DTS) + r * 128;
    f32x4 acc[4][4];
#pragma unroll
    for (int mt = 0; mt < 4; ++mt)
#pragma unroll
        for (int nt = 0; nt < 4; ++nt) acc[mt][nt] = (f32x4){0.f, 0.f, 0.f, 0.f};
    {
#pragma unroll
        for (int ks = 0; ks < 4; ++ks) {
            bf16x8 af[4];
#pragma unroll
            for (int mt = 0; mt < 4; ++mt) af[mt] = lds128(lds, CM + ((lh * 64 + mt * 16 + lr) * 136 + ks * 32 + q * 8) * 2);
#pragma unroll
            for (int nt = 0; nt < 4; ++nt)
#pragma unroll
                for (int mt = 0; mt < 4; ++mt) acc[mt][nt] = mma(acc[mt][nt], af[mt], pv[ks][nt]);
        }
    }
    float al[4];
#pragma unroll
    for (int mt = 0; mt < 4; ++mt) { al[mt] = acum[lh * 64 + mt * 16 + lr]; const float sc = ex(al[mt]);
#pragma unroll
        for (int nt = 0; nt < 4; ++nt) acc[mt][nt] = acc[mt][nt] * sc; }
#pragma unroll 1
    for (int ks = 0; ks <= lh * 2 + 1; ++ks) {
        const int s0 = ks * 32 + q * 8;
        const f32x4 as0 = *(const LAS f32x4*)(acum + s0), as1 = *(const LAS f32x4*)(acum + s0 + 4), dd0 = *(const LAS f32x4*)(dts + s0), dd1 = *(const LAS f32x4*)(dts + s0 + 4);
        bf16x8 bx[4];
#pragma unroll
        for (int nt = 0; nt < 4; ++nt) bx[nt] = lds128(lds, XST + ((r * 64 + nt * 16 + lr) * 136 + s0) * 2);
#pragma unroll
        for (int mt = 0; mt < 4; ++mt) {
            if (lh * 64 + mt * 16 + 15 < ks * 32) continue;
            const int l = lh * 64 + mt * 16 + lr;
            const u32x4 raw = *(const LAS u32x4*)(lds + BM + (l * 136 + s0) * 2);
            float w[8];
            w[0] = bflo(raw.x); w[1] = bfhi(raw.x); w[2] = bflo(raw.y); w[3] = bfhi(raw.y); w[4] = bflo(raw.z); w[5] = bfhi(raw.z); w[6] = bflo(raw.w); w[7] = bfhi(raw.w);
#pragma unroll
            for (int e = 0; e < 8; ++e) {
                const float as = e < 4 ? as0[e & 3] : as1[e & 3], dd = e < 4 ? dd0[e & 3] : dd1[e & 3];
                const bool valid = (s0 + e) <= l;
                const float arg = valid ? (al[mt] - as) : 0.f;
                w[e] = valid ? w[e] * ex(arg) * dd : 0.f;
            }
            u32x4 pw; pw.x = pk2(w[0], w[1]); pw.y = pk2(w[2], w[3]); pw.z = pk2(w[4], w[5]); pw.w = pk2(w[6], w[7]);
            const bf16x8 af = __builtin_bit_cast(bf16x8, pw);
#pragma unroll
            for (int nt = 0; nt < 4; ++nt) acc[mt][nt] = mma(acc[mt][nt], af, bx[nt]);
        }
    }
    const float dsk = d_skip[h];
#pragma unroll
    for (int mt = 0; mt < 4; ++mt) {
        const int l = lh * 64 + mt * 16 + lr; float ssq = 0.f;
#pragma unroll
        for (int nt = 0; nt < 4; ++nt) {
            const int ch = r * 64 + nt * 16 + q * 4;
            const u32x2 zz = *(const u32x2*)(MIX + (grow0 + l) * 2048 + 1024 + g * 256 + ch);
            float xs[4], zf[4];
            zf[0] = bflo(zz.x); zf[1] = bfhi(zz.x); zf[2] = bflo(zz.y); zf[3] = bfhi(zz.y);
#pragma unroll
            for (int j = 0; j < 4; ++j) xs[j] = __uint_as_float(((unsigned)*(const LAS unsigned short*)(lds + XST + ((ch + j) * 136 + l) * 2)) << 16);
#pragma unroll
            for (int j = 0; j < 4; ++j) { const float y = (acc[mt][nt][j] + dsk * xs[j]) * silu(zf[j]); acc[mt][nt][j] = y; ssq += y * y; }
        }
        ssq += __shfl_xor(ssq, 16); ssq += __shfl_xor(ssq, 32);
        if (q == 0) ((LAS float*)(lds + PSS))[r * 128 + l] = ssq;
        __builtin_amdgcn_sched_barrier(0);
    }
    __syncthreads();
#pragma unroll
    for (int mt = 0; mt < 4; ++mt) {
        const int l = lh * 64 + mt * 16 + lr; const LAS float* pss = (const LAS float*)(lds + PSS);
        const float tot = (pss[l] + pss[128 + l]) + (pss[256 + l] + pss[384 + l]);
        const float rs = rsqrtf(tot * (1.f / 256.f) + 1e-5f);
#pragma unroll
        for (int nt = 0; nt < 4; ++nt) {
            const int ch = r * 64 + nt * 16 + q * 4;
            const f32x4 ng = *(const f32x4*)(norm_g + g * 256 + ch);
            u32x2 w; w.x = pk2(acc[mt][nt][0] * rs * ng.x, acc[mt][nt][1] * rs * ng.y); w.y = pk2(acc[mt][nt][2] * rs * ng.z, acc[mt][nt][3] * rs * ng.w);
            *(u32x2*)(MIX + (grow0 + l) * 2048 + 1024 + g * 256 + ch) = w;
        }
        __builtin_amdgcn_sched_barrier(0);
    }
    __syncthreads();
}

__device__ __forceinline__ void attn_tile(const Args& a, LAS unsigned char* lds, int tile, int tid, int lane, int wave) {
    constexpr int KB = 0, VT = 36864;
    const int kvh = tile & 1, bn = tile >> 1, nb = bn & 31;
    const bf16* QKV = (const bf16*)(a.ws + WS_QKV); bf16* ATT = (bf16*)(a.ws + WS_ATT); const float* sinks = a.in[20];
    if (tid < 256) {
        const int d0 = (tid & 7) * 8, s0 = (tid >> 3) * 8;
        u32x4 v[8];
#pragma unroll
        for (int j = 0; j < 8; ++j) { const int sk = s0 + j; v[j] = (u32x4){0u, 0u, 0u, 0u};
            if (nb > 0 || sk >= 128) v[j] = *(const u32x4*)(QKV + ((long)bn * 128 - 128 + sk) * QKVD + 1152 + kvh * 64 + d0); }
#pragma unroll
        for (int e = 0; e < 8; ++e) {
            unsigned hh[8];
#pragma unroll
            for (int j = 0; j < 8; ++j) { const unsigned wd = v[j][e >> 1]; hh[j] = (e & 1) ? (wd >> 16) : (wd & 0xffffu); }
            u32x4 w; w.x = hh[0] | (hh[1] << 16); w.y = hh[2] | (hh[3] << 16); w.z = hh[4] | (hh[5] << 16); w.w = hh[6] | (hh[7] << 16);
            *(LAS u32x4*)(lds + VT + ((d0 + e) * 264 + s0) * 2) = w;
        }
    } else {
        const int t2 = tid - 256;
#pragma unroll
        for (int i = 0; i < 8; ++i) {
            const int p = t2 + 256 * i, sk = p >> 3, pc = p & 7;
            u32x4 kv = {0u, 0u, 0u, 0u};
            if (nb > 0 || sk >= 128) kv = *(const u32x4*)(QKV + ((long)bn * 128 - 128 + sk) * QKVD + 1024 + kvh * 64 + pc * 8);
            *(LAS u32x4*)(lds + KB + (sk * 72 + pc * 8) * 2) = kv;
        }
    }
    __syncthreads();
    const int h = kvh * 8 + wave, lr = lane & 15, q4 = lane >> 4; const float sink = sinks[h];
    bf16x8 aqn[2];
#pragma unroll
    for (int ks = 0; ks < 2; ++ks) aqn[ks] = *(const bf16x8*)(QKV + ((size_t)bn * 128 + lr) * QKVD + h * 64 + ks * 32 + q4 * 8);
#pragma unroll 1
    for (int qc = 0; qc < 8; ++qc) {
        const int qi = qc * 16 + lr; const size_t qrow = (size_t)bn * 128 + qi;
        bf16x8 aq[2];
#pragma unroll
        for (int ks = 0; ks < 2; ++ks) aq[ks] = aqn[ks];
        { const size_t qnext = qrow + (qc < 7 ? 16 : 0);
#pragma unroll
          for (int ks = 0; ks < 2; ++ks) aqn[ks] = *(const bf16x8*)(QKV + qnext * QKVD + h * 64 + ks * 32 + q4 * 8); }
        f32x4 sc[10];
#pragma unroll
        for (int t = 0; t < 9; ++t) {
            sc[t] = (f32x4){0.f, 0.f, 0.f, 0.f};
#pragma unroll
            for (int ks = 0; ks < 2; ++ks) sc[t] = mma(sc[t], aq[ks], lds128(lds, KB + (((qc + t) * 16 + lr) * 72 + ks * 32 + q4 * 8) * 2));
        }
        sc[9] = (f32x4){0.f, 0.f, 0.f, 0.f};
        float m = sink;
#pragma unroll
        for (int t = 0; t < 9; ++t)
#pragma unroll
            for (int j = 0; j < 4; ++j) {
                const int si = (qc + t) * 16 + q4 * 4 + j;
                const bool valid = (si >= qi + 1) && (si <= qi + 128) && (nb > 0 || si >= 128);
                const float v = valid ? sc[t][j] * 0.125f : -INFINITY;
                sc[t][j] = v; m = fmaxf(m, v);
            }
        m = fmaxf(m, __shfl_xor(m, 16)); m = fmaxf(m, __shfl_xor(m, 32));
        float sum = 0.f;
#pragma unroll
        for (int t = 0; t < 9; ++t)
#pragma unroll
            for (int j = 0; j < 4; ++j) { const float p = ex(sc[t][j] - m); sc[t][j] = p; sum += p; }
        sum += __shfl_xor(sum, 16); sum += __shfl_xor(sum, 32);
        const float inv = 1.f / (sum + ex(sink - m));
        f32x4 o[4];
#pragma unroll
        for (int dt = 0; dt < 4; ++dt) o[dt] = (f32x4){0.f, 0.f, 0.f, 0.f};
#pragma unroll
        for (int kk = 0; kk < 5; ++kk) {
            const int t0 = 2 * kk, t1 = 2 * kk + 1;
            u32x4 pw; pw.x = pk2(sc[t0][0], sc[t0][1]); pw.y = pk2(sc[t0][2], sc[t0][3]); pw.z = pk2(sc[t1][0], sc[t1][1]); pw.w = pk2(sc[t1][2], sc[t1][3]);
            const bf16x8 af = __builtin_bit_cast(bf16x8, pw);
            const int T0 = qc + t0, T1 = (qc + t1) > 15 ? 15 : (qc + t1);
#pragma unroll
            for (int dt = 0; dt < 4; ++dt) {
                const u32x2 b0 = *(const LAS u32x2*)(lds + VT + ((dt * 16 + lr) * 264 + T0 * 16 + q4 * 4) * 2), b1 = *(const LAS u32x2*)(lds + VT + ((dt * 16 + lr) * 264 + T1 * 16 + q4 * 4) * 2);
                u32x4 bw; bw.x = b0.x; bw.y = b0.y; bw.z = b1.x; bw.w = b1.y;
                o[dt] = mma(o[dt], af, __builtin_bit_cast(bf16x8, bw));
            }
        }
#pragma unroll
        for (int dt = 0; dt < 4; ++dt) {
            u32x2 w; w.x = pk2(o[dt][0] * inv, o[dt][1] * inv); w.y = pk2(o[dt][2] * inv, o[dt][3] * inv);
            *(u32x2*)(ATT + qrow * 1024 + h * 64 + dt * 16 + q4 * 4) = w;
        }
    }
    __syncthreads();
}

__device__ __forceinline__ float wave_sum(float v) {
#pragma unroll
    for (int o = 1; o < 64; o <<= 1) v += __shfl_xor(v, o);
    return v;
}

#define XB_TMO      128
#define XB_XCNT(j)  (256  + 64 * (j))
#define XB_XSUB(j)  (1280 + 64 * (j))
#define XB_XGEN(j)  (2304 + 64 * (j))
#define XB_TOP      3328
#define XB_TOPGEN   3392
#define XCD_BAR_WORDS 3456
#define XB_SPIN_CAP (1u << 18)

__device__ __forceinline__ unsigned xb_ld(unsigned* p)              { return __hip_atomic_load(p, __ATOMIC_RELAXED, __HIP_MEMORY_SCOPE_AGENT); }
__device__ __forceinline__ unsigned xb_add(unsigned* p, unsigned v) { return __hip_atomic_fetch_add(p, v, __ATOMIC_RELAXED, __HIP_MEMORY_SCOPE_AGENT); }
__device__ __forceinline__ unsigned xb_xcc_id() { return (unsigned)__builtin_amdgcn_s_getreg((3 << 11) | 20) & 0xFu; }
#define XB_SPIN(cond, bar) do { unsigned _sp = 0; while (cond) { __builtin_amdgcn_s_sleep(1); \
    if ((++_sp & 255u) == 0u) { if (xb_ld(&(bar)[XB_TMO])) break; if (_sp > XB_SPIN_CAP) { atomicAdd(&(bar)[XB_TMO], 1u); break; } } } } while (0)

struct XcdBarrier {
    unsigned* bar; unsigned x;
    volatile LAS unsigned* st;
};

__device__ __forceinline__ XcdBarrier xcd_barrier_post(unsigned* bar, volatile LAS unsigned* st) {
    XcdBarrier b; b.bar = bar; b.x = xb_xcc_id(); b.st = st;
    if (threadIdx.x == 0) (void)xb_add(&bar[XB_XCNT(b.x)], 1u);
    return b;
}
__device__ __forceinline__ void xcd_barrier_complete(unsigned* bar, unsigned x, unsigned& nloc, unsigned& nx) {
    const unsigned G = gridDim.x * gridDim.y * gridDim.z;
    unsigned sum, cnt, mine, sp = 0u;
    for (;;) {
        sum = 0u; cnt = 0u; mine = 0u;
#pragma unroll
        for (unsigned j = 0; j < 16; ++j) { const unsigned c = xb_ld(&bar[XB_XCNT(j)]); sum += c; cnt += (c > 0u) ? 1u : 0u; mine = (j == x) ? c : mine; }
        if (sum == G) break;
        __builtin_amdgcn_s_sleep(1);
        if ((++sp & 255u) == 0u) { if (xb_ld(&bar[XB_TMO])) break; if (sp > XB_SPIN_CAP) { atomicAdd(&bar[XB_TMO], 1u); break; } }
    }
    nloc = mine > 0u ? mine : 1u; nx = cnt > 0u ? cnt : 1u;
}

__device__ __forceinline__ void xcd_barrier(const XcdBarrier& b) {
    asm volatile("s_waitcnt vmcnt(0)" ::: "memory");
    __syncthreads();
    if (threadIdx.x == 0) {
        unsigned* bar = b.bar;
        __builtin_amdgcn_s_waitcnt(0);
        unsigned nloc = b.st[0], nx = b.st[1];
        if (nloc == 0u) { xcd_barrier_complete(bar, b.x, nloc, nx); b.st[0] = nloc; b.st[1] = nx; }
        const unsigned old = xb_add(&bar[XB_XSUB(b.x)], 1u);
        const unsigned gen = old / nloc;
        if (old + 1u == (gen + 1u) * nloc) {
            __builtin_amdgcn_fence(__ATOMIC_RELEASE, "agent");
            asm volatile("s_waitcnt vmcnt(0)" ::: "memory");
            const unsigned og = xb_add(&bar[XB_TOP], 1u);
            const unsigned tg = og / nx;
            if (og + 1u == (tg + 1u) * nx) xb_add(&bar[XB_TOPGEN], 1u);
            else XB_SPIN(xb_ld(&bar[XB_TOPGEN]) == tg, bar);
            __builtin_amdgcn_fence(__ATOMIC_ACQUIRE, "agent");
            xb_add(&bar[XB_XGEN(b.x)], 1u);
            asm volatile("s_waitcnt vmcnt(0)" ::: "memory");
        } else {
            XB_SPIN(xb_ld(&bar[XB_XGEN(b.x)]) == gen, bar);
            __builtin_amdgcn_fence(__ATOMIC_ACQUIRE, "agent");
            asm volatile("s_waitcnt vmcnt(0)" ::: "memory");
        }
    }
    __syncthreads();
}

__global__ void __launch_bounds__(512, 2) hybrid_fwd(Args args) {
    extern __shared__ __attribute__((aligned(16))) unsigned char lds_raw[];
    LAS unsigned char* lds = (LAS unsigned char*)lds_raw;
    const int tid = threadIdx.x, lane = tid & 63, wave = __builtin_amdgcn_readfirstlane(tid >> 6), G = gridDim.x;
    unsigned char* ws = args.ws;
    const int lo = args.ph_lo, hi = args.ph_hi;
    cg::grid_group grid = cg::this_grid();
    if (lo > hi) grid.sync();
    volatile LAS unsigned* bst = (volatile LAS unsigned*)(lds + LDS_BYTES - 16);
    if (tid < 4) bst[tid] = 0u;
    __syncthreads();
    XcdBarrier bar = xcd_barrier_post((unsigned*)ws, bst);
#ifndef PH_MASK
#define PH_MASK 0x3fff
#endif
#define IN(k) (((PH_MASK >> (k)) & 1) && lo <= (k) && (k) < hi)
#define SEAM(k) do { if (IN(k) && IN((k) + 1)) { xcd_barrier(bar); } } while (0)
    bf16* XB = (bf16*)(ws + WS_XB); float* SSP = (float*)(ws + WS_SSP); float* H = args.out;

    if (IN(0)) { phase0(args, lds, tid, lane, wave, G); } SEAM(0);
    if (IN(1)) {
        pg8::Gemm g{XB, (const bf16*)(ws + WS_WIN), MTOK, NPROJ, DM}; pg8::StaticOrder S; S.init(MTOK, NPROJ, G, (int)blockIdx.x);
        EpiInProj E{SSP, (bf16*)(ws + WS_MIX), (bf16*)(ws + WS_GV), (bf16*)(ws + WS_XBC), (float*)(ws + WS_LNP)};
        pg8::gemm_phase<EpiInProj, pg8::StaticOrder, true, true>(lds, g, S, E);
    } SEAM(1);
    if (IN(2)) {
        for (int t = blockIdx.x; t < 1024 + 2048; t += G) { if (t < 1024) ssd_a_tile(args, lds, t, tid, lane, wave); else gmlp_tile(args, lds, t - 1024, tid, lane, wave); }
    } SEAM(2);
    if (IN(3)) { scan_phase(args, tid, G); } SEAM(3);
    if (IN(4)) { for (int t = blockIdx.x; t < 1024; t += G) ssd_b_tile(args, lds, t, tid, lane, wave); } SEAM(4);
    if (IN(5)) {
        pg8::Gemm g{(const bf16*)(ws + WS_MIX), (const bf16*)(ws + WS_WOUT), MTOK, DM, 2048}; pg8::StaticOrder S; S.init(MTOK, DM, G, (int)blockIdx.x);
        EpiResid E{XB, SSP, nullptr};
        pg8::gemm_phase<EpiResid, pg8::StaticOrder, true, true>(lds, g, S, E);
    } SEAM(5);
    if (IN(6)) {
        pg8::Gemm g{XB, (const bf16*)(ws + WS_WUP0), MTOK, DFF, DM}; pg8::StaticOrder S; S.init(MTOK, DFF, G, (int)blockIdx.x);
        EpiRelu2 E{SSP, (bf16*)(ws + WS_HID)};
        pg8::gemm_phase<EpiRelu2, pg8::StaticOrder, true, true>(lds, g, S, E);
    } SEAM(6);
    if (IN(7)) {
        pg8::Gemm g{(const bf16*)(ws + WS_HID), (const bf16*)(ws + WS_WDN0), MTOK, DM, DFF, HIDP}; pg8::StaticOrder S; S.init(MTOK, DM, G, (int)blockIdx.x);
        EpiResid E{XB, SSP, nullptr};
        pg8::gemm_phase<EpiResid, pg8::StaticOrder, true, true>(lds, g, S, E);
    } SEAM(7);
    if (IN(8)) {
        pg8::Gemm g{XB, (const bf16*)(ws + WS_WQKV), MTOK, QKVD, DM}; pg8::StaticOrder S; S.init(MTOK, QKVD, G, (int)blockIdx.x);
        EpiQKV E{SSP, (bf16*)(ws + WS_QKV), args.in[17]};
        pg8::gemm_phase<EpiQKV, pg8::StaticOrder, true, true>(lds, g, S, E);
    } SEAM(8);
    if (IN(9)) { for (int t = blockIdx.x; t < 512; t += G) attn_tile(args, lds, t, tid, lane, wave); } SEAM(9);
    if (IN(10)) {
        pg8::Gemm g{(const bf16*)(ws + WS_ATT), (const bf16*)(ws + WS_WO), MTOK, DM, DM}; pg8::StaticOrder S; S.init(MTOK, DM, G, (int)blockIdx.x);
        EpiResid E{XB, SSP, args.in[19]};
        pg8::gemm_phase<EpiResid, pg8::StaticOrder, true, true>(lds, g, S, E);
    } SEAM(10);
    if (IN(11)) {
        pg8::Gemm g{XB, (const bf16*)(ws + WS_WUP1), MTOK, DFF, DM}; pg8::StaticOrder S; S.init(MTOK, DFF, G, (int)blockIdx.x);
        EpiRelu2 E{SSP, (bf16*)(ws + WS_HID)};
        pg8::gemm_phase<EpiRelu2, pg8::StaticOrder, true, true>(lds, g, S, E);
    } SEAM(11);
    if (IN(12)) {
        pg8::Gemm g{(const bf16*)(ws + WS_HID), (const bf16*)(ws + WS_WDN1), MTOK, DM, DFF, HIDP}; pg8::StaticOrder S; S.init(MTOK, DM, G, (int)blockIdx.x);
        EpiResid E{XB, SSP, nullptr};
        pg8::gemm_phase<EpiResid, pg8::StaticOrder, true, true>(lds, g, S, E);
    } SEAM(12);
    if (IN(13)) {
        const float* fg = args.in[3];
        f32x4 gv[2][2];
#pragma unroll
        for (int j = 0; j < 2; ++j) { gv[j][0] = *(const f32x4*)(fg + j * 512 + lane * 8); gv[j][1] = *(const f32x4*)(fg + j * 512 + lane * 8 + 4); }
        for (int m = blockIdx.x * 8 + wave; m < MTOK; m += G * 8) {
            f32x4 v[2][2]; float sq = 0.f;
#pragma unroll
            for (int j = 0; j < 2; ++j) { const u32x4 r = *(const u32x4*)(XB + (size_t)m * DM + j * 512 + lane * 8);
                v[j][0] = (f32x4){bflo(r.x), bfhi(r.x), bflo(r.y), bfhi(r.y)}; v[j][1] = (f32x4){bflo(r.z), bfhi(r.z), bflo(r.w), bfhi(r.w)};
#pragma unroll
                for (int k = 0; k < 2; ++k) sq += (v[j][k].x * v[j][k].x + v[j][k].y * v[j][k].y) + (v[j][k].z * v[j][k].z + v[j][k].w * v[j][k].w); }
            const float rs = rsqrtf(wave_sum(sq) * (1.f / 1024.f) + 1e-5f);
#pragma unroll
            for (int j = 0; j < 2; ++j)
#pragma unroll
                for (int k = 0; k < 2; ++k) *(f32x4*)(H + (size_t)m * DM + j * 512 + lane * 8 + k * 4) = v[j][k] * rs * gv[j][k];
        }
    }
#ifdef DBG_STOP
    if (lo == 100) {
        const unsigned short* base = (const unsigned short*)(ws + (size_t)DBG_LO * MiB); const size_t n = (size_t)(DBG_HI - DBG_LO) * MiB / 2;
        for (size_t i = (size_t)blockIdx.x * 512 + tid; i < (size_t)MTOK * DM; i += (size_t)G * 512) { float sum = 0.f; for (size_t e = i; e < n; e += (size_t)MTOK * DM) sum += (float)base[e]; args.out[i] = sum; }
    }
#endif
#undef IN
#undef SEAM
}

#ifndef MK_N_LAUNCHES
#define MK_N_LAUNCHES 14
#endif

__global__ void dbg_fill(float* o, size_t n, float v) { for (size_t i = (size_t)blockIdx.x * 256 + threadIdx.x; i < n; i += (size_t)gridDim.x * 256) o[i] = v; }
extern "C" void kernel_launch(void* const* d_in, const int* in_sizes, int n_in, void* d_out, int out_size, void* d_ws, size_t ws_size, hipStream_t stream) {
    static int grid = 0;
    if (grid == 0) {
        if (n_in != 23 || in_sizes[0] != MTOK * DM || out_size != MTOK * DM || ws_size < WS_END) {
            fprintf(stderr, "kernel_launch: unexpected shapes: n_in %d in0 %d out %d ws %zu (need %zu)\n", n_in, n_in > 0 ? in_sizes[0] : -1, out_size, ws_size, (size_t)WS_END); grid = -1; return; }
        int dev = 0, cus = 0, per_cu = 0;
        if (hipGetDevice(&dev) != hipSuccess || hipDeviceGetAttribute(&cus, hipDeviceAttributeMultiprocessorCount, dev) != hipSuccess) { fprintf(stderr, "kernel_launch: device query failed\n"); grid = -1; return; }
        if (hipFuncSetAttribute((const void*)hybrid_fwd, hipFuncAttributeMaxDynamicSharedMemorySize, LDS_BYTES) != hipSuccess) { fprintf(stderr, "kernel_launch: hipFuncSetAttribute failed\n"); grid = -1; return; }
        if (hipOccupancyMaxActiveBlocksPerMultiprocessor(&per_cu, (const void*)hybrid_fwd, 512, LDS_BYTES) != hipSuccess || per_cu < 1) { fprintf(stderr, "kernel_launch: occupancy query says %d\n", per_cu); per_cu = 1; }
        (void)hipGetLastError();
        grid = cus * per_cu;
    }
    if (grid < 0) return;
    if (hipMemsetAsync(d_ws, 0, 16384, stream) != hipSuccess) { fprintf(stderr, "kernel_launch: memset failed\n"); return; }
    Args a{};
    for (int i = 0; i < 23; ++i) a.in[i] = (const float*)d_in[i];
    a.out = (float*)d_out; a.ws = (unsigned char*)d_ws;
#if MK_N_LAUNCHES == 1
    a.ph_lo = 0; a.ph_hi = NPHASE;
    void* kargs[] = {&a};
    hipError_t e = hipLaunchCooperativeKernel((const void*)hybrid_fwd, dim3(grid), dim3(512), kargs, LDS_BYTES, stream);
    if (e != hipSuccess) fprintf(stderr, "kernel_launch: cooperative launch failed: %s (grid %d)\n", hipGetErrorString(e), grid);
#else
#ifdef DBG_STOP
    for (int p = 0; p <= DBG_STOP; ++p) { a.ph_lo = p; a.ph_hi = p + 1; hipLaunchKernelGGL(hybrid_fwd, dim3(grid), dim3(512), LDS_BYTES, stream, a); }
    if (DBG_HI > DBG_LO) { a.ph_lo = 100; a.ph_hi = 101; hipLaunchKernelGGL(hybrid_fwd, dim3(grid), dim3(512), LDS_BYTES, stream, a); }
#else
    for (int p = 0; p < NPHASE; ++p) { a.ph_lo = p; a.ph_hi = p + 1; hipLaunchKernelGGL(hybrid_fwd, dim3(grid), dim3(512), LDS_BYTES, stream, a); }
#endif
#endif
}
```

```cpp
#define MK_N_LAUNCHES 1
#include <hip/hip_runtime.h>
#include <hip/hip_cooperative_groups.h>
#include <cstdio>
#include <cstdint>
namespace cg = cooperative_groups;
namespace pg8 {
#define PG8_LAS __attribute__((address_space(3)))
typedef unsigned short bf16_t;
typedef short bf16x8 __attribute__((ext_vector_type(8)));
typedef float f32x4 __attribute__((ext_vector_type(4)));
typedef unsigned u32x4 __attribute__((ext_vector_type(4)));
constexpr int BM = 256, BK = 64, HALF = 128, HTB = HALF * BK * 2  , STAGE_BYTES = 8 * HTB, NXCD = 8, WGM = 8;

__host__ __device__ __forceinline__ int lds_byte(int r, int c) { const int st = (r >> 4) * 2 + (c >> 5), rr = r & 15, cc = c & 31, ob = rr * 64 + cc * 2; return st * 1024 + (ob ^ (((ob >> 9) & 1) << 5)); }
__host__ __device__ __forceinline__ void stage_rc(int b, int& R, int& C) { const int st = b / 1024, sb = b % 1024, swz = sb ^ (((sb >> 9) & 1) << 5); R = (st >> 1) * 16 + swz / 64; C = (st & 1) * 32 + (swz % 64) / 2; }
__host__ __device__ __forceinline__ int perm32(int rho) { const int n = rho >> 4, i = rho & 15; return 8 * (i >> 2) + 4 * n + (i & 3); }

struct Unit { int pm, pn; };
struct Gemm { const bf16_t* A; const bf16_t* Bt; int M, N, K; int lda; };

struct StaticOrder {
    int nM, nN, nwg, G, c;
    __host__ __device__ void init(int M, int N, int G_, int c_) { nM = M / BM; nN = N / BM; nwg = nM * nN; G = G_; c = c_; }
    __host__ __device__ bool next(int i, Unit& u) const {
        const long L = (long)i * G + c; if (L >= nwg) return false;
        int wgid = (int)L; { const int q = nwg / NXCD, r = nwg % NXCD, xcd = wgid % NXCD, off = wgid / NXCD; wgid = (xcd < r ? xcd * (q + 1) : r * (q + 1) + (xcd - r) * q) + off; }
        const int nig = WGM * nN, gid = wgid / nig, fm = gid * WGM, gsz = (nM - fm) < WGM ? (nM - fm) : WGM;
        u.pm = fm + ((wgid % nig) % gsz); u.pn = (wgid % nig) / gsz; return true;
    }
    __device__ __forceinline__ void a_ready(const Unit&) const {}
    __device__ __forceinline__ void done(const Unit&) const {}
};

__device__ __forceinline__ unsigned cvt_pk_bf16(float lo, float hi) { unsigned r; asm volatile("v_cvt_pk_bf16_f32 %0, %1, %2" : "=v"(r) : "v"(lo), "v"(hi)); return r; }
typedef float f32x2 __attribute__((ext_vector_type(2)));
template <class Epi, class Sched, bool ALIGN_EPI = false, bool SP2 = false>
__device__ __forceinline__ void gemm_phase(PG8_LAS unsigned char* lds, const Gemm g, const Sched& S, const Epi& E) {
    const int tid = threadIdx.x, wid = __builtin_amdgcn_readfirstlane(tid >> 6), lane = tid & 63, wr = wid >> 2, wc = wid & 3, fr = lane & 15, fq = lane >> 4;
    const int K = g.K, nt = K / BK, lda = g.lda ? g.lda : g.K;
    unsigned voffA[2], voffB[2];
#pragma unroll
    for (int i = 0; i < 2; ++i) { int R, C; stage_rc(tid * 16 + i * 8192, R, C); const int Rb = Epi::PERM ? ((R & ~31) + perm32(R & 31)) : R;
        voffA[i] = (unsigned)(R * lda + C) * 2u; voffB[i] = (unsigned)(Rb * K + C) * 2u; }
    const size_t kstep = (size_t)(BK * 2);
    const size_t hstep = (size_t)HALF * K * 2;
    const size_t tstep = 2 * hstep; const size_t hstepA = (size_t)HALF * lda * 2, tstepA = 2 * hstepA;
    const unsigned ldsw = (unsigned)wid * 1024u;
    const int aoff = lds_byte(wr * 64 + fr, fq * 8), boff = lds_byte(wc * 32 + fr, fq * 8);
#define PG8_SA(b, h) (((b) * 2 + (h)) * HTB)
#define PG8_SB(b, h) ((4 + (b) * 2 + (h)) * HTB)
#define PG8_STAGE(bufoff, gbase, voff) do { _Pragma("unroll") for (int _i = 0; _i < 2; ++_i) \
        __builtin_amdgcn_global_load_lds((const unsigned*)((const char*)(gbase) + (voff)[_i]), (PG8_LAS unsigned*)(lds + (bufoff) + ldsw + _i * 8192), 16, 0, 0); } while (0)
#define PG8_LDA(dst, b, h) do { _Pragma("unroll") for (int m = 0; m < 4; ++m) _Pragma("unroll") for (int k = 0; k < 2; ++k) dst[m][k] = *(const PG8_LAS bf16x8*)(lds + PG8_SA(b, h) + aoff + m * 2048 + k * 1024); } while (0)
#define PG8_LDB(dst, b, h) do { _Pragma("unroll") for (int n = 0; n < 2; ++n) _Pragma("unroll") for (int k = 0; k < 2; ++k) dst[n][k] = *(const PG8_LAS bf16x8*)(lds + PG8_SB(b, h) + boff + n * 2048 + k * 1024); } while (0)
#define PG8_MMA(ai, bj, At, Bt) do { __builtin_amdgcn_s_setprio(1); _Pragma("unroll") for (int m = 0; m < 4; ++m) _Pragma("unroll") for (int n = 0; n < 2; ++n) _Pragma("unroll") for (int k = 0; k < 2; ++k) \
        acc[ai][bj][m][n] = __builtin_amdgcn_mfma_f32_16x16x32_bf16(Bt[n][k], At[m][k], acc[ai][bj][m][n], 0, 0, 0); __builtin_amdgcn_s_setprio(0); } while (0)
#define PG8_WAIT_V(n) asm volatile("s_waitcnt vmcnt(" #n ")" ::: "memory")
#define PG8_WAIT_L(n) asm volatile("s_waitcnt lgkmcnt(" #n ")" ::: "memory")
#define PG8_BAR __builtin_amdgcn_s_barrier()
#define PG8_SCHED __builtin_amdgcn_sched_barrier(0)
    Unit cur, nxt; int ui = 0;
    if (!S.next(0, cur)) return;
    f32x4 acc[2][2][4][2];
#pragma unroll
    for (int a = 0; a < 2; ++a)
#pragma unroll
        for (int b = 0; b < 2; ++b)
#pragma unroll
            for (int m = 0; m < 4; ++m)
#pragma unroll
                for (int n = 0; n < 2; ++n) acc[a][b][m][n] = (f32x4){0.f, 0.f, 0.f, 0.f};
    bf16x8 At[4][2], B0[2][2], B1[2][2];
    const char* cA = (const char*)g.A + (size_t)cur.pm * tstepA; const char* cB = (const char*)g.Bt + (size_t)cur.pn * tstep;
    S.a_ready(cur);
    if constexpr (SP2) {
        PG8_STAGE(PG8_SB(0, 0), cB, voffB); PG8_STAGE(PG8_SB(0, 1), cB + hstep, voffB); PG8_STAGE(PG8_SA(0, 0), cA, voffA); PG8_STAGE(PG8_SA(0, 1), cA + hstepA, voffA);
        if (wr == 1) PG8_BAR;
        PG8_WAIT_V(2); PG8_BAR;
        PG8_STAGE(PG8_SB(1, 0), cB + kstep, voffB); PG8_STAGE(PG8_SA(1, 0), cA + kstep, voffA); PG8_STAGE(PG8_SB(1, 1), cB + hstep + kstep, voffB);
        PG8_WAIT_V(6); PG8_BAR;
    } else {
        PG8_STAGE(PG8_SB(0, 0), cB, voffB); PG8_STAGE(PG8_SA(0, 0), cA, voffA); PG8_STAGE(PG8_SB(0, 1), cB + hstep, voffB); PG8_STAGE(PG8_SA(0, 1), cA + hstepA, voffA);
        if (wr == 1) PG8_BAR;
        PG8_WAIT_V(4); PG8_BAR;
        PG8_STAGE(PG8_SB(1, 0), cB + kstep, voffB); PG8_STAGE(PG8_SA(1, 0), cA + kstep, voffA); PG8_STAGE(PG8_SB(1, 1), cB + hstep + kstep, voffB);
        PG8_WAIT_V(6); PG8_BAR;
    }
    for (;;) {
        const bool has_next = S.next(ui + 1, nxt);
        const char* nA = has_next ? (const char*)g.A + (size_t)nxt.pm * tstepA : cA; const char* nB = has_next ? (const char*)g.Bt + (size_t)nxt.pn * tstep : cB;
        for (int t = 0; t < nt; t += 2) {
            const bool last = (t == nt - 2);
            const char* a1 = cA + (size_t)(t + 1) * kstep;
            const char* a2 = last ? nA : cA + (size_t)(t + 2) * kstep; const char* b2 = last ? nB : cB + (size_t)(t + 2) * kstep;
            const char* a3 = a2 + kstep; const char* b3 = b2 + kstep;
            if (last && has_next) S.a_ready(nxt);
            if constexpr (SP2) {
            PG8_LDB(B0, 0, 0); PG8_LDB(B1, 0, 1); PG8_SCHED; PG8_LDA(At, 0, 0); PG8_STAGE(PG8_SA(1, 1), a1 + hstepA, voffA);
            PG8_WAIT_V(8); PG8_WAIT_L(0); PG8_BAR; PG8_MMA(0, 0, At, B0); PG8_MMA(0, 1, At, B1); PG8_BAR; PG8_SCHED;
            PG8_LDA(At, 0, 1); PG8_STAGE(PG8_SB(0, 0), b2, voffB); PG8_STAGE(PG8_SB(0, 1), b2 + hstep, voffB); PG8_STAGE(PG8_SA(0, 0), a2, voffA);
            PG8_WAIT_V(8); PG8_WAIT_L(0); PG8_BAR; PG8_MMA(1, 0, At, B0); PG8_MMA(1, 1, At, B1); PG8_BAR; PG8_SCHED;
            PG8_LDB(B0, 1, 0); PG8_LDB(B1, 1, 1); PG8_SCHED; PG8_LDA(At, 1, 0); PG8_STAGE(PG8_SA(0, 1), a2 + hstepA, voffA);
            PG8_WAIT_V(8); PG8_WAIT_L(0); PG8_BAR; PG8_MMA(0, 0, At, B0); PG8_MMA(0, 1, At, B1); PG8_BAR; PG8_SCHED;
            PG8_LDA(At, 1, 1); PG8_STAGE(PG8_SB(1, 0), b3, voffB); PG8_STAGE(PG8_SB(1, 1), b3 + hstep, voffB); PG8_STAGE(PG8_SA(1, 0), a3, voffA);
            PG8_WAIT_V(8); PG8_WAIT_L(0); PG8_BAR; PG8_MMA(1, 0, At, B0); PG8_MMA(1, 1, At, B1); PG8_BAR; PG8_SCHED;
            } else {
            PG8_LDB(B0, 0, 0); PG8_SCHED; PG8_LDA(At, 0, 0); PG8_STAGE(PG8_SA(1, 1), a1 + hstepA, voffA);
            PG8_WAIT_L(8); PG8_BAR; PG8_WAIT_L(0); PG8_MMA(0, 0, At, B0); PG8_BAR; PG8_SCHED;
            PG8_LDB(B1, 0, 1); PG8_STAGE(PG8_SB(0, 0), b2, voffB);
            PG8_BAR; PG8_WAIT_L(0); PG8_MMA(0, 1, At, B1); PG8_BAR;
            PG8_LDA(At, 0, 1); PG8_STAGE(PG8_SA(0, 0), a2, voffA);
            PG8_BAR; PG8_WAIT_L(0); PG8_MMA(1, 0, At, B0); PG8_BAR; PG8_SCHED;
            PG8_STAGE(PG8_SB(0, 1), b2 + hstep, voffB);
            PG8_WAIT_V(6); PG8_BAR; PG8_MMA(1, 1, At, B1); PG8_BAR;
            PG8_LDB(B0, 1, 0); PG8_SCHED; PG8_LDA(At, 1, 0); PG8_STAGE(PG8_SA(0, 1), a2 + hstepA, voffA);
            PG8_WAIT_L(8); PG8_BAR; PG8_WAIT_L(0); PG8_MMA(0, 0, At, B0); PG8_BAR; PG8_SCHED;
            PG8_LDB(B1, 1, 1); PG8_STAGE(PG8_SB(1, 0), b3, voffB);
            PG8_BAR; PG8_WAIT_L(0); PG8_MMA(0, 1, At, B1); PG8_BAR;
            PG8_LDA(At, 1, 1); PG8_STAGE(PG8_SA(1, 0), a3, voffA);
            PG8_BAR; PG8_WAIT_L(0); PG8_MMA(1, 0, At, B0); PG8_BAR; PG8_SCHED;
            PG8_STAGE(PG8_SB(1, 1), b3 + hstep, voffB);
            PG8_WAIT_V(6); PG8_BAR; PG8_MMA(1, 1, At, B1); PG8_BAR;
            }
        }
        if constexpr (ALIGN_EPI) { if (wr == 0) PG8_BAR; }
        if constexpr (!Epi::AFTER_DRAIN) { E(acc, cur, wr, wc, fr, fq); S.done(cur); }
        if (!has_next) break;
#pragma unroll
        for (int a = 0; a < 2; ++a)
#pragma unroll
            for (int b = 0; b < 2; ++b)
#pragma unroll
                for (int m = 0; m < 4; ++m)
#pragma unroll
                    for (int n = 0; n < 2; ++n) acc[a][b][m][n] = (f32x4){0.f, 0.f, 0.f, 0.f};
        cur = nxt; cA = nA; cB = nB; ++ui;
        if constexpr (ALIGN_EPI) { if (wr == 1) PG8_BAR; }
    }
    PG8_WAIT_V(0);
    if constexpr (!ALIGN_EPI) { if (wr == 0) PG8_BAR; }
    PG8_BAR;
    if constexpr (Epi::AFTER_DRAIN) { E.fused(acc, cur, wr, wc, fr, fq, lds, wid, lane); S.done(cur); }
#undef PG8_SA
#undef PG8_SB
#undef PG8_STAGE
#undef PG8_LDA
#undef PG8_LDB
#undef PG8_MMA
#undef PG8_WAIT_V
#undef PG8_WAIT_L
#undef PG8_BAR
#undef PG8_SCHED
}
}

#define LAS __attribute__((address_space(3)))
typedef unsigned short bf16;
typedef unsigned u32x4 __attribute__((ext_vector_type(4)));
typedef unsigned u32x2 __attribute__((ext_vector_type(2)));
typedef float f32x4 __attribute__((ext_vector_type(4)));
typedef float f32x2 __attribute__((ext_vector_type(2)));
typedef short bf16x8 __attribute__((ext_vector_type(8)));
#define LDS_WAIT() asm volatile("s_waitcnt lgkmcnt(0)" ::: "memory")

constexpr int MTOK = 32768, DM = 1024, DFF = 4096, QKVD = 1280, INEV = 5136, NPROJ = 5120;
constexpr size_t MiB = 1u << 20;
constexpr size_t WS_WGM = 1 * MiB, WS_WIN = 2 * MiB, WS_WOUT = 12 * MiB, WS_WUP0 = 16 * MiB, WS_WUP1 = 24 * MiB, WS_WDN0 = 32 * MiB, WS_WDN1 = 40 * MiB,
                 WS_WQKV = 48 * MiB, WS_WO = 51 * MiB, WS_DT = 53 * MiB, WS_SSP = 55 * MiB, WS_LNP = 57 * MiB, WS_DEC = 61 * MiB, WS_XB = 62 * MiB, WS_ST = 126 * MiB,
                 WS_MIX = 190 * MiB, WS_GV = 318 * MiB, WS_XBC = 382 * MiB, WS_HID = 190 * MiB, WS_QKV = 190 * MiB, WS_ATT = 270 * MiB, WS_END = 510 * MiB;
constexpr int LDS_BYTES = 147456;
constexpr int HIDP = DFF + 64;
constexpr int NPHASE = 14;

typedef __bf16 bf16x2_t __attribute__((ext_vector_type(2)));
__device__ __forceinline__ unsigned pk2(float lo, float hi) { const f32x2 v = {lo, hi}; const bf16x2_t b = __builtin_convertvector(v, bf16x2_t); return __builtin_bit_cast(unsigned, b); }
__device__ __forceinline__ float bflo(unsigned u) { return __uint_as_float(u << 16); }
__device__ __forceinline__ float bfhi(unsigned u) { return __uint_as_float(u & 0xffff0000u); }
__device__ __forceinline__ float ex(float x) { return __builtin_amdgcn_exp2f(x * 1.4426950408889634f); }
__device__ __forceinline__ float rcp(float x) { return __builtin_amdgcn_rcpf(x); }
__device__ __forceinline__ float gelu_t(float x) { const float u = 1.5957691216057308f * (x + 0.044715f * x * x * x); return x * rcp(1.f + ex(-u)); }
__device__ __forceinline__ float silu(float x) { return x * rcp(1.f + ex(-x)); }
__device__ __forceinline__ f32x4 mma(f32x4 acc, bf16x8 a, bf16x8 b) { return __builtin_amdgcn_mfma_f32_16x16x32_bf16(b, a, acc, 0, 0, 0); }
__device__ __forceinline__ int slot32(int n) { return (n & ~31) | (((n >> 2) & 1) << 4) | (((n >> 3) & 3) << 2) | (n & 3); }
__device__ __forceinline__ int unslot32(int s) { return (s & ~31) | (((s >> 2) & 3) << 3) | (((s >> 4) & 1) << 2) | (s & 3); }
__device__ __forceinline__ bf16x8 lds128(LAS unsigned char* lds, int byteoff) { return *(const LAS bf16x8*)(lds + byteoff); }
__device__ __forceinline__ void st16(LAS unsigned char* lds, int byteoff, unsigned v) { *(LAS unsigned short*)(lds + byteoff) = (unsigned short)v; }

struct Args { const float* in[23]; float* out; unsigned char* ws; int ph_lo, ph_hi; };

__device__ __forceinline__ float row_rstd(const float* ssp, size_t row, int fq) {
    const f32x4 p = *(const f32x4*)(ssp + row * 16 + fq * 4);
    float s = (p.x + p.y) + (p.z + p.w);
    s += __shfl_xor(s, 16); s += __shfl_xor(s, 32);
    return rsqrtf(s * (1.f / 1024.f) + 1e-5f);
}
struct EpiInProj {
    static constexpr bool PERM = true, AFTER_DRAIN = false;
    const float* ssp; bf16* mix; bf16* gv; bf16* xbc; float* lnp;
    __device__ __forceinline__ void operator()(const f32x4 (&acc)[2][2][4][2], const pg8::Unit& u, int wr, int wc, int fr, int fq) const {
        const size_t row0 = (size_t)u.pm * 256 + wr * 64 + fr; const int cl = wc * 32 + 8 * fq; const int pn = u.pn;
        bf16* dst; int ld; bool act = false, stats = false;
        if (pn < 4) { dst = mix + pn * 256; ld = 2048; act = true; }
        else if (pn < 8) { dst = gv + (pn - 4) * 256; ld = 1024; act = true; stats = true; }
        else if (pn < 12) { dst = mix + 1024 + (pn - 8) * 256; ld = 2048; }
        else { dst = xbc + (pn - 12) * 256; ld = 2048; }
#pragma unroll
        for (int ai = 0; ai < 2; ++ai)
#pragma unroll
            for (int m = 0; m < 4; ++m) {
                const size_t row = row0 + ai * 128 + m * 16; const float rs = row_rstd(ssp, row, fq);
                float s1 = 0.f, s2 = 0.f;
#pragma unroll
                for (int bj = 0; bj < 2; ++bj) {
                    f32x4 v0 = acc[ai][bj][m][0] * rs, v1 = acc[ai][bj][m][1] * rs;
                    if (act) {
#pragma unroll
                        for (int j = 0; j < 4; ++j) { v0[j] = gelu_t(v0[j]); v1[j] = gelu_t(v1[j]); }
                    }
                    if (stats) {
#pragma unroll
                        for (int j = 0; j < 4; ++j) { s1 += v0[j] + v1[j]; s2 += v0[j] * v0[j] + v1[j] * v1[j]; }
                    }
                    u32x4 w; w.x = pk2(v0[0], v0[1]); w.y = pk2(v0[2], v0[3]); w.z = pk2(v1[0], v1[1]); w.w = pk2(v1[2], v1[3]);
                    *(u32x4*)(dst + row * ld + bj * 128 + cl) = w;
                }
                if (stats) {
                    s1 += __shfl_xor(s1, 16); s1 += __shfl_xor(s1, 32); s2 += __shfl_xor(s2, 16); s2 += __shfl_xor(s2, 32);
                    if (fq == 0) { f32x2 o; o.x = s1; o.y = s2; *(f32x2*)(lnp + (row * 16 + (pn - 4) * 4 + wc) * 2) = o; }
                }
            }
    }
};
struct EpiResid {
    static constexpr bool PERM = true, AFTER_DRAIN = false;
    bf16* xb; float* ssp; const float* bias;
    __device__ __forceinline__ void operator()(const f32x4 (&acc)[2][2][4][2], const pg8::Unit& u, int wr, int wc, int fr, int fq) const {
        const size_t row0 = (size_t)u.pm * 256 + wr * 64 + fr; const int col0 = u.pn * 256 + wc * 32 + 8 * fq;
        f32x4 bv[2][2];
#pragma unroll
        for (int bj = 0; bj < 2; ++bj)
#pragma unroll
            for (int n = 0; n < 2; ++n) bv[bj][n] = bias ? *(const f32x4*)(bias + col0 + bj * 128 + 4 * n) : (f32x4){0.f, 0.f, 0.f, 0.f};
#pragma unroll
        for (int ai = 0; ai < 2; ++ai)
#pragma unroll
            for (int m = 0; m < 4; ++m) {
                const size_t row = row0 + ai * 128 + m * 16; float ss = 0.f;
#pragma unroll
                for (int bj = 0; bj < 2; ++bj) {
                    const size_t off = row * 1024 + col0 + bj * 128;
                    const u32x4 rv = *(const u32x4*)(xb + off);
                    f32x4 v0 = acc[ai][bj][m][0] + bv[bj][0], v1 = acc[ai][bj][m][1] + bv[bj][1];
                    v0[0] += bflo(rv.x); v0[1] += bfhi(rv.x); v0[2] += bflo(rv.y); v0[3] += bfhi(rv.y); v1[0] += bflo(rv.z); v1[1] += bfhi(rv.z); v1[2] += bflo(rv.w); v1[3] += bfhi(rv.w);
#pragma unroll
                    for (int j = 0; j < 4; ++j) ss += v0[j] * v0[j] + v1[j] * v1[j];
                    u32x4 w; w.x = pk2(v0[0], v0[1]); w.y = pk2(v0[2], v0[3]); w.z = pk2(v1[0], v1[1]); w.w = pk2(v1[2], v1[3]);
                    *(u32x4*)(xb + off) = w;
                }
                ss += __shfl_xor(ss, 16); ss += __shfl_xor(ss, 32);
                if (fq == 0) ssp[row * 16 + u.pn * 4 + wc] = ss;
            }
    }
};
struct EpiRelu2 {
    static constexpr bool PERM = true, AFTER_DRAIN = false;
    const float* ssp; bf16* hid;
    __device__ __forceinline__ void operator()(const f32x4 (&acc)[2][2][4][2], const pg8::Unit& u, int wr, int wc, int fr, int fq) const {
        const size_t row0 = (size_t)u.pm * 256 + wr * 64 + fr; const int col0 = u.pn * 256 + wc * 32 + 8 * fq;
#pragma unroll
        for (int ai = 0; ai < 2; ++ai)
#pragma unroll
            for (int m = 0; m < 4; ++m) {
                const size_t row = row0 + ai * 128 + m * 16; const float rs = row_rstd(ssp, row, fq);
#pragma unroll
                for (int bj = 0; bj < 2; ++bj) {
                    f32x4 v0 = acc[ai][bj][m][0] * rs, v1 = acc[ai][bj][m][1] * rs;
#pragma unroll
                    for (int j = 0; j < 4; ++j) { const float a = fmaxf(v0[j], 0.f), b = fmaxf(v1[j], 0.f); v0[j] = a * a; v1[j] = b * b; }
                    u32x4 w; w.x = pk2(v0[0], v0[1]); w.y = pk2(v0[2], v0[3]); w.z = pk2(v1[0], v1[1]); w.w = pk2(v1[2], v1[3]);
                    *(u32x4*)(hid + row * HIDP + col0 + bj * 128) = w;
                }
            }
    }
};
struct EpiQKV {
    static constexpr bool PERM = true, AFTER_DRAIN = false;
    const float* ssp; bf16* o; const float* bias;
    __device__ __forceinline__ void operator()(const f32x4 (&acc)[2][2][4][2], const pg8::Unit& u, int wr, int wc, int fr, int fq) const {
        const size_t row0 = (size_t)u.pm * 256 + wr * 64 + fr; const int col0 = u.pn * 256 + wc * 32 + 8 * fq;
        f32x4 bv[2][2];
#pragma unroll
        for (int bj = 0; bj < 2; ++bj)
#pragma unroll
            for (int n = 0; n < 2; ++n) bv[bj][n] = *(const f32x4*)(bias + col0 + bj * 128 + 4 * n);
#pragma unroll
        for (int ai = 0; ai < 2; ++ai)
#pragma unroll
            for (int m = 0; m < 4; ++m) {
                const size_t row = row0 + ai * 128 + m * 16; const float rs = row_rstd(ssp, row, fq);
#pragma unroll
                for (int bj = 0; bj < 2; ++bj) {
                    const f32x4 v0 = acc[ai][bj][m][0] * rs + bv[bj][0], v1 = acc[ai][bj][m][1] * rs + bv[bj][1];
                    u32x4 w; w.x = pk2(v0[0], v0[1]); w.y = pk2(v0[2], v0[3]); w.z = pk2(v1[0], v1[1]); w.w = pk2(v1[2], v1[3]);
                    *(u32x4*)(o + row * QKVD + col0 + bj * 128) = w;
                }
            }
    }
};

__device__ __forceinline__ void p0_transpose_item(const float* __restrict__ W, int ldw, int K, int nblk, bf16* WT, const float* __restrict__ gain, LAS float* scr, int item, int lane) {
    const int kb = item / nblk, nb = item % nblk, k0 = 64 * kb, n0 = 32 * nb;
#pragma unroll
    for (int i = 0; i < 8; ++i) {
        const int kk = 8 * i + (lane >> 3), c4 = (lane & 7) * 4; const float gs = gain ? gain[k0 + kk] : 1.f;
        const f32x4 v = *(const f32x4*)(W + (size_t)(k0 + kk) * ldw + n0 + c4);
        scr[kk * 33 + c4] = v.x * gs; scr[kk * 33 + c4 + 1] = v.y * gs; scr[kk * 33 + c4 + 2] = v.z * gs; scr[kk * 33 + c4 + 3] = v.w * gs;
    }
    LDS_WAIT(); asm volatile("" ::: "memory");
    const int c = lane & 7;
#pragma unroll
    for (int j = 0; j < 4; ++j) { const int n = (lane >> 3) + 8 * j; const LAS float* s = scr + (8 * c) * 33 + n;
        u32x4 o; o.x = pk2(s[0 * 33], s[1 * 33]); o.y = pk2(s[2 * 33], s[3 * 33]); o.z = pk2(s[4 * 33], s[5 * 33]); o.w = pk2(s[6 * 33], s[7 * 33]);
        *(u32x4*)(WT + (size_t)(n0 + n) * K + k0 + 8 * c) = o; }
    LDS_WAIT(); asm volatile("" ::: "memory");
}

__device__ __forceinline__ void phase0(const Args& a, LAS unsigned char* lds, int tid, int lane, int wave, int G) {
    const float* x = a.in[0]; const float* g_mix = a.in[1]; const float* g_mlp = a.in[2]; const float* w_in = a.in[4]; const float* w_out = a.in[5];
    const float* gm_w = a.in[8]; const float* dt_bias = a.in[12]; const float* w_qkv = a.in[16]; const float* w_o = a.in[18]; const float* w_up = a.in[21]; const float* w_dn = a.in[22];
    unsigned char* ws = a.ws;
    bf16* XB = (bf16*)(ws + WS_XB); float* DT = (float*)(ws + WS_DT); float* SSP = (float*)(ws + WS_SSP);
    for (int idx = tid; idx < 16384; idx += 512) { const int k = idx >> 4, j = idx & 15; const float v = w_in[(size_t)k * INEV + NPROJ + j] * g_mix[k]; st16(lds, (j * 1032 + k) * 2, pk2(v, v)); }
    __syncthreads();
    const int gw = blockIdx.x * 8 + wave, NGW = G * 8;
    for (int item = gw; item < MTOK / 16; item += NGW) {
        const int r = lane & 15, q = lane >> 4; const size_t row = (size_t)item * 16 + r;
        const float* xp = x + row * DM + q * 8; bf16* xo = XB + row * DM + q * 8;
        f32x4 acc = {0.f, 0.f, 0.f, 0.f}; float ss = 0.f;
#pragma unroll 8
        for (int kk = 0; kk < 32; ++kk) {
            const f32x4 v0 = *(const f32x4*)(xp + kk * 32), v1 = *(const f32x4*)(xp + kk * 32 + 4);
            ss += (v0.x * v0.x + v0.y * v0.y) + (v0.z * v0.z + v0.w * v0.w) + (v1.x * v1.x + v1.y * v1.y) + (v1.z * v1.z + v1.w * v1.w);
            u32x4 w; w.x = pk2(v0.x, v0.y); w.y = pk2(v0.z, v0.w); w.z = pk2(v1.x, v1.y); w.w = pk2(v1.z, v1.w);
            *(u32x4*)(xo + kk * 32) = w;
            const bf16x8 bfr = lds128(lds, (r * 1032 + kk * 32 + q * 8) * 2);
            acc = mma(acc, __builtin_bit_cast(bf16x8, w), bfr);
        }
        ss += __shfl_xor(ss, 16); ss += __shfl_xor(ss, 32);
        const float rstd = rsqrtf(ss * (1.f / 1024.f) + 1e-5f);
        const f32x4 bias = *(const f32x4*)(dt_bias + q * 4);
        f32x4 o;
#pragma unroll
        for (int j = 0; j < 4; ++j) { const float v = acc[j] * rstd + bias[j]; o[j] = v > 20.f ? v : log1pf(expf(v)); }
        *(f32x4*)(DT + row * 16 + q * 4) = o;
        f32x4 sp = {q == 0 ? ss : 0.f, 0.f, 0.f, 0.f};
        *(f32x4*)(SSP + row * 16 + q * 4) = sp;
    }
    __syncthreads();
    LAS float* scr = (LAS float*)(lds + wave * 16384);
    constexpr int I_IN = 16 * 160, I_OUT = 32 * 32, I_UP = 16 * 128, I_DN = 64 * 32, I_QKV = 16 * 40, I_O = 16 * 32;
    constexpr int NITEMS = I_IN + I_OUT + 2 * I_UP + 2 * I_DN + I_QKV + I_O;
    for (int it = gw; it < NITEMS; it += NGW) {
        int r = it;
        if (r < I_IN) { p0_transpose_item(w_in, INEV, 1024, 160, (bf16*)(ws + WS_WIN), g_mix, scr, r, lane); continue; } r -= I_IN;
        if (r < I_OUT) { p0_transpose_item(w_out, 1024, 2048, 32, (bf16*)(ws + WS_WOUT), nullptr, scr, r, lane); continue; } r -= I_OUT;
        if (r < I_UP) { p0_transpose_item(w_up, 4096, 1024, 128, (bf16*)(ws + WS_WUP0), g_mlp, scr, r, lane); continue; } r -= I_UP;
        if (r < I_UP) { p0_transpose_item(w_up + (size_t)1024 * 4096, 4096, 1024, 128, (bf16*)(ws + WS_WUP1), g_mlp + 1024, scr, r, lane); continue; } r -= I_UP;
        if (r < I_DN) { p0_transpose_item(w_dn, 1024, 4096, 32, (bf16*)(ws + WS_WDN0), nullptr, scr, r, lane); continue; } r -= I_DN;
        if (r < I_DN) { p0_transpose_item(w_dn + (size_t)4096 * 1024, 1024, 4096, 32, (bf16*)(ws + WS_WDN1), nullptr, scr, r, lane); continue; } r -= I_DN;
        if (r < I_QKV) { p0_transpose_item(w_qkv, 1280, 1024, 40, (bf16*)(ws + WS_WQKV), g_mix + 1024, scr, r, lane); continue; } r -= I_QKV;
        p0_transpose_item(w_o, 1024, 1024, 32, (bf16*)(ws + WS_WO), nullptr, scr, r, lane);
    }
    bf16* WGM = (bf16*)(ws + WS_WGM);
    for (int idx = blockIdx.x * 512 + tid; idx < 8 * 128 * 128; idx += G * 512) { const int t = (idx >> 7) & 127, s = idx & 127; const float v = (s <= t) ? gm_w[idx] : 0.f; WGM[idx] = (bf16)(pk2(v, v) & 0xffffu); }
}

__device__ __forceinline__ void conv8(const bf16* __restrict__ XBC, size_t grow0, int l, bool first, int col, const float* __restrict__ cw, const float* __restrict__ cb, float (&o)[8]) {
    const f32x4 b0 = *(const f32x4*)(cb + col), b1 = *(const f32x4*)(cb + col + 4);
    o[0] = b0.x; o[1] = b0.y; o[2] = b0.z; o[3] = b0.w; o[4] = b1.x; o[5] = b1.y; o[6] = b1.z; o[7] = b1.w;
#pragma unroll
    for (int tap = 0; tap < 4; ++tap) {
        const int t = l - 3 + tap;
        u32x4 v = {0u, 0u, 0u, 0u};
        if (!first || t >= 0) v = *(const u32x4*)(XBC + (size_t)((long)grow0 + t) * 2048 + col);
        const f32x4 w0 = *(const f32x4*)(cw + tap * 2048 + col), w1 = *(const f32x4*)(cw + tap * 2048 + col + 4);
        o[0] += w0.x * bflo(v.x); o[1] += w0.y * bfhi(v.x); o[2] += w0.z * bflo(v.y); o[3] += w0.w * bfhi(v.y);
        o[4] += w1.x * bflo(v.z); o[5] += w1.y * bfhi(v.z); o[6] += w1.z * bflo(v.w); o[7] += w1.w * bfhi(v.w);
    }
#pragma unroll
    for (int e = 0; e < 8; ++e) o[e] = silu(o[e]);
}
__device__ __forceinline__ void conv8x8(const bf16* __restrict__ XBC, size_t grow0, int l0, bool first, int col, const float* __restrict__ cw, const float* __restrict__ cb, float (&o)[8][8]) {
    float w[4][8];
#pragma unroll
    for (int tap = 0; tap < 4; ++tap) { const f32x4 w0 = *(const f32x4*)(cw + tap * 2048 + col), w1 = *(const f32x4*)(cw + tap * 2048 + col + 4);
        w[tap][0] = w0.x; w[tap][1] = w0.y; w[tap][2] = w0.z; w[tap][3] = w0.w; w[tap][4] = w1.x; w[tap][5] = w1.y; w[tap][6] = w1.z; w[tap][7] = w1.w; }
    { const f32x4 b0 = *(const f32x4*)(cb + col), b1 = *(const f32x4*)(cb + col + 4);
#pragma unroll
      for (int j = 0; j < 8; ++j) { o[j][0] = b0.x; o[j][1] = b0.y; o[j][2] = b0.z; o[j][3] = b0.w; o[j][4] = b1.x; o[j][5] = b1.y; o[j][6] = b1.z; o[j][7] = b1.w; } }
#pragma unroll
    for (int rr = 0; rr < 11; ++rr) {
        const int t = l0 - 3 + rr;
        u32x4 v = {0u, 0u, 0u, 0u};
        if (!first || t >= 0) v = *(const u32x4*)(XBC + (size_t)((long)grow0 + t) * 2048 + col);
        float x[8];
        x[0] = bflo(v.x); x[1] = bfhi(v.x); x[2] = bflo(v.y); x[3] = bfhi(v.y); x[4] = bflo(v.z); x[5] = bfhi(v.z); x[6] = bflo(v.w); x[7] = bfhi(v.w);
#pragma unroll
        for (int tap = 0; tap < 4; ++tap) { const int j = rr - tap; if (j >= 0 && j < 8) {
#pragma unroll
            for (int e = 0; e < 8; ++e) o[j][e] += w[tap][e] * x[e]; } }
    }
#pragma unroll
    for (int j = 0; j < 8; ++j)
#pragma unroll
        for (int e = 0; e < 8; ++e) o[j][e] = silu(o[j][e]);
}
__device__ __forceinline__ float ssd_scan(const float* __restrict__ DT, const float* __restrict__ a_log, size_t grow0, int h, int r, int lane, LAS float* acum, LAS float* dts, float& a0o, float& a1o, float& d0o, float& d1o) {
    const float A = -expf(a_log[h]);
    const float d0 = DT[(grow0 + 2 * lane) * 16 + h], d1 = DT[(grow0 + 2 * lane + 1) * 16 + h];
    const float v0 = d0 * A, v1 = d1 * A, s = v0 + v1;
    float inc = s;
#pragma unroll
    for (int o = 1; o < 64; o <<= 1) { const float t = __shfl_up(inc, o); if (lane >= o) inc += t; }
    const float exc = inc - s, a0 = exc + v0, a1 = exc + s;
    acum[r * 128 + 2 * lane] = a0; acum[r * 128 + 2 * lane + 1] = a1; dts[r * 128 + 2 * lane] = d0; dts[r * 128 + 2 * lane + 1] = d1;
    a0o = a0; a1o = a1; d0o = d0; d1o = d1;
    return __shfl(a1, 63);
}

__device__ __forceinline__ void ssd_a_tile(const Args& a, LAS unsigned char* lds, int tile, int tid, int lane, int wave) {
    { int tz; asm volatile("v_mov_b32 %0, 0" : "=v"(tz)); tid += tz; lane += tz; }
    constexpr int XST = 0, BT = 69632, ACUM = 104448, DTS = ACUM + 2048, TOE = DTS + 2048;
    const int g = tile & 3, bc = tile >> 2, c = bc & 31; const size_t grow0 = (size_t)bc * 128;
    unsigned char* ws = a.ws; const bf16* XBC = (const bf16*)(ws + WS_XBC); const float* DT = (const float*)(ws + WS_DT); float* DEC = (float*)(ws + WS_DEC); bf16* ST = (bf16*)(ws + WS_ST);
    const float* cw = a.in[10]; const float* cb = a.in[11]; const float* a_log = a.in[13];
    if (wave < 4) {
        float a0, a1, d0, d1; const float tot = ssd_scan(DT, a_log, grow0, g * 4 + wave, wave, lane, (LAS float*)(lds + ACUM), (LAS float*)(lds + DTS), a0, a1, d0, d1);
        LAS float* toe = (LAS float*)(lds + TOE);
        toe[wave * 128 + 2 * lane] = ex(tot - a0) * d0; toe[wave * 128 + 2 * lane + 1] = ex(tot - a1) * d1;
        if (lane == 0) DEC[((bc >> 5) * 16 + g * 4 + wave) * 32 + c] = ex(tot);
    }
    __syncthreads();
    {
        const bool first = (c == 0);
        float o[8][8];
        {
            const int chg = tid & 31, l0 = (tid >> 5) * 8;
            conv8x8(XBC, grow0, l0, first, g * 256 + chg * 8, cw, cb, o);
            const LAS float* toe = (const LAS float*)(lds + TOE) + (chg >> 3) * 128 + l0;
            const f32x4 t0 = *(const LAS f32x4*)toe, t1 = *(const LAS f32x4*)(toe + 4);
#pragma unroll
            for (int e = 0; e < 8; ++e) {
                u32x4 w; w.x = pk2(o[0][e] * t0.x, o[1][e] * t0.y); w.y = pk2(o[2][e] * t0.z, o[3][e] * t0.w); w.z = pk2(o[4][e] * t1.x, o[5][e] * t1.y); w.w = pk2(o[6][e] * t1.z, o[7][e] * t1.w);
                *(LAS u32x4*)(lds + XST + ((chg * 8 + e) * 136 + l0) * 2) = w;
            }
        }
        if (tid < 256) {
            const int chg = tid & 15, l0 = (tid >> 4) * 8;
            conv8x8(XBC, grow0, l0, first, 1024 + g * 128 + chg * 8, cw, cb, o);
#pragma unroll
            for (int e = 0; e < 8; ++e) {
                u32x4 w; w.x = pk2(o[0][e], o[1][e]); w.y = pk2(o[2][e], o[3][e]); w.z = pk2(o[4][e], o[5][e]); w.w = pk2(o[6][e], o[7][e]);
                *(LAS u32x4*)(lds + BT + (slot32(chg * 8 + e) * 136 + l0) * 2) = w;
            }
        }
    }
    __syncthreads();
    {
        const int r = wave >> 1, ph = wave & 1, lr = lane & 15, q = lane >> 4;
        f32x4 acc[2][8];
#pragma unroll
        for (int mt = 0; mt < 2; ++mt)
#pragma unroll
            for (int nt = 0; nt < 8; ++nt) acc[mt][nt] = (f32x4){0.f, 0.f, 0.f, 0.f};
#pragma unroll
        for (int ks = 0; ks < 4; ++ks) {
            bf16x8 af[2];
#pragma unroll
            for (int mt = 0; mt < 2; ++mt) af[mt] = lds128(lds, XST + ((r * 64 + ph * 32 + mt * 16 + lr) * 136 + ks * 32 + q * 8) * 2);
#pragma unroll
            for (int nt = 0; nt < 8; ++nt) {
                const bf16x8 bfr = lds128(lds, BT + ((nt * 16 + lr) * 136 + ks * 32 + q * 8) * 2);
#pragma unroll
                for (int mt = 0; mt < 2; ++mt) acc[mt][nt] = mma(acc[mt][nt], af[mt], bfr);
            }
        }
        bf16* stp = ST + ((size_t)bc * 16 + g * 4 + r) * 8192;
#pragma unroll
        for (int mt = 0; mt < 2; ++mt)
#pragma unroll
            for (int G2 = 0; G2 < 4; ++G2) {
                const int p = ph * 32 + mt * 16 + lr, n = G2 * 32 + q * 8;
                u32x4 w; w.x = pk2(acc[mt][2 * G2][0], acc[mt][2 * G2][1]); w.y = pk2(acc[mt][2 * G2][2], acc[mt][2 * G2][3]);
                w.z = pk2(acc[mt][2 * G2 + 1][0], acc[mt][2 * G2 + 1][1]); w.w = pk2(acc[mt][2 * G2 + 1][2], acc[mt][2 * G2 + 1][3]);
                *(u32x4*)(stp + p * 128 + n) = w;
            }
    }
    __syncthreads();
}

__device__ __forceinline__ void gmlp_tile(const Args& a, LAS unsigned char* lds, int tile, int tid, int lane, int wave) {
    constexpr int VNT = 0;
    const int g = tile & 7, bc = tile >> 3; const size_t grow0 = (size_t)bc * 128;
    unsigned char* ws = a.ws; const bf16* GV = (const bf16*)(ws + WS_GV); const float* LNP = (const float*)(ws + WS_LNP); bf16* MIX = (bf16*)(ws + WS_MIX); const bf16* WGM = (const bf16*)(ws + WS_WGM);
    const float* ln_g = a.in[6]; const float* ln_b = a.in[7]; const float* b_s = a.in[9];
    {
        const int srow = tid >> 2, part = tid & 3; const size_t row = grow0 + srow;
        const f32x4 p0 = *(const f32x4*)(LNP + row * 32 + part * 8), p1 = *(const f32x4*)(LNP + row * 32 + part * 8 + 4);
        float s1 = (p0.x + p0.z) + (p1.x + p1.z), s2 = (p0.y + p0.w) + (p1.y + p1.w);
        s1 += __shfl_xor(s1, 1); s1 += __shfl_xor(s1, 2); s2 += __shfl_xor(s2, 1); s2 += __shfl_xor(s2, 2);
        const float mean = s1 * (1.f / 1024.f), var = s2 * (1.f / 1024.f) - mean * mean, rstd = rsqrtf(var + 1e-5f);
        if (part == 0) { f32x2 ms; ms.x = mean; ms.y = rstd; *(LAS f32x2*)(lds + 34816 + srow * 8) = ms; }
    }
    __syncthreads();
    {
        const int chg = tid & 15, s0 = (tid >> 4) * 4, ch = g * 128 + chg * 8;
        const f32x4 g0 = *(const f32x4*)(ln_g + ch), g1 = *(const f32x4*)(ln_g + ch + 4), c0 = *(const f32x4*)(ln_b + ch), c1 = *(const f32x4*)(ln_b + ch + 4);
        float val[4][8];
#pragma unroll
        for (int jj = 0; jj < 4; ++jj) {
            const u32x4 v = *(const u32x4*)(GV + (grow0 + s0 + jj) * 1024 + ch);
            const f32x2 ms = *(const LAS f32x2*)(lds + 34816 + (s0 + jj) * 8);
            const float mean = ms.x, rstd = ms.y;
            val[jj][0] = (bflo(v.x) - mean) * rstd * g0.x + c0.x; val[jj][1] = (bfhi(v.x) - mean) * rstd * g0.y + c0.y; val[jj][2] = (bflo(v.y) - mean) * rstd * g0.z + c0.z; val[jj][3] = (bfhi(v.y) - mean) * rstd * g0.w + c0.w;
            val[jj][4] = (bflo(v.z) - mean) * rstd * g1.x + c1.x; val[jj][5] = (bfhi(v.z) - mean) * rstd * g1.y + c1.y; val[jj][6] = (bflo(v.w) - mean) * rstd * g1.z + c1.z; val[jj][7] = (bfhi(v.w) - mean) * rstd * g1.w + c1.w;
        }
#pragma unroll
        for (int e = 0; e < 8; ++e) { u32x2 w; w.x = pk2(val[0][e], val[1][e]); w.y = pk2(val[2][e], val[3][e]); *(LAS u32x2*)(lds + VNT + (slot32(chg * 8 + e) * 136 + s0) * 2) = w; }
    }
    __syncthreads();
    {
        const int wr = wave >> 1, wc = wave & 1, lr = lane & 15, q = lane >> 4;
        f32x4 acc[2][4];
#pragma unroll
        for (int mt = 0; mt < 2; ++mt)
#pragma unroll
            for (int nt = 0; nt < 4; ++nt) acc[mt][nt] = (f32x4){0.f, 0.f, 0.f, 0.f};
        for (int ks = 0; ks <= wr; ++ks) {
            bf16x8 af[2];
#pragma unroll
            for (int mt = 0; mt < 2; ++mt) af[mt] = *(const bf16x8*)(WGM + g * 16384 + (wr * 32 + mt * 16 + lr) * 128 + ks * 32 + q * 8);
#pragma unroll
            for (int nt = 0; nt < 4; ++nt) {
                const bf16x8 bfr = lds128(lds, VNT + ((wc * 64 + nt * 16 + lr) * 136 + ks * 32 + q * 8) * 2);
#pragma unroll
                for (int mt = 0; mt < 2; ++mt) acc[mt][nt] = mma(acc[mt][nt], af[mt], bfr);
            }
        }
#pragma unroll
        for (int mt = 0; mt < 2; ++mt) {
            const int t = wr * 32 + mt * 16 + lr; const float bias = b_s[g * 128 + t];
#pragma unroll
            for (int G2 = 0; G2 < 2; ++G2) {
                bf16* p = MIX + (grow0 + t) * 2048 + g * 128 + wc * 64 + G2 * 32 + q * 8;
                const u32x4 uu = *(const u32x4*)p;
                u32x4 w; w.x = pk2((acc[mt][2 * G2][0] + bias) * bflo(uu.x), (acc[mt][2 * G2][1] + bias) * bfhi(uu.x)); w.y = pk2((acc[mt][2 * G2][2] + bias) * bflo(uu.y), (acc[mt][2 * G2][3] + bias) * bfhi(uu.y));
                w.z = pk2((acc[mt][2 * G2 + 1][0] + bias) * bflo(uu.z), (acc[mt][2 * G2 + 1][1] + bias) * bfhi(uu.z)); w.w = pk2((acc[mt][2 * G2 + 1][2] + bias) * bflo(uu.w), (acc[mt][2 * G2 + 1][3] + bias) * bfhi(uu.w));
                *(u32x4*)p = w;
            }
        }
    }
    __syncthreads();
}

__device__ __forceinline__ void scan_phase(const Args& a, int tid, int G) {
    bf16* ST = (bf16*)(a.ws + WS_ST); const float* DEC = (const float*)(a.ws + WS_DEC);
    for (int idx = blockIdx.x * 512 + tid; idx < 131072; idx += G * 512) {
        const int pn8 = idx & 1023, h = (idx >> 10) & 15, b = idx >> 14;
        float st[8];
#pragma unroll
        for (int e = 0; e < 8; ++e) st[e] = 0.f;
#pragma unroll 1
        for (int c0 = 0; c0 < 32; c0 += 8) {
            u32x4 v[8]; float dec[8];
#pragma unroll
            for (int cc = 0; cc < 8; ++cc) { const size_t bch = ((size_t)(b * 32 + c0 + cc)) * 16 + h; v[cc] = *(const u32x4*)(ST + bch * 8192 + pn8 * 8); }
            { const f32x4 d0 = *(const f32x4*)(DEC + (b * 16 + h) * 32 + c0), d1 = *(const f32x4*)(DEC + (b * 16 + h) * 32 + c0 + 4);
              dec[0] = d0.x; dec[1] = d0.y; dec[2] = d0.z; dec[3] = d0.w; dec[4] = d1.x; dec[5] = d1.y; dec[6] = d1.z; dec[7] = d1.w; }
#pragma unroll
            for (int cc = 0; cc < 8; ++cc) {
                const size_t bch = ((size_t)(b * 32 + c0 + cc)) * 16 + h;
                u32x4 w; w.x = pk2(st[0], st[1]); w.y = pk2(st[2], st[3]); w.z = pk2(st[4], st[5]); w.w = pk2(st[6], st[7]);
                *(u32x4*)(ST + bch * 8192 + pn8 * 8) = w;
                const float d = dec[cc];
                st[0] = d * st[0] + bflo(v[cc].x); st[1] = d * st[1] + bfhi(v[cc].x); st[2] = d * st[2] + bflo(v[cc].y); st[3] = d * st[3] + bfhi(v[cc].y);
                st[4] = d * st[4] + bflo(v[cc].z); st[5] = d * st[5] + bfhi(v[cc].z); st[6] = d * st[6] + bflo(v[cc].w); st[7] = d * st[7] + bfhi(v[cc].w);
            }
        }
    }
}

__device__ __forceinline__ void ssd_b_tile(const Args& a, LAS unsigned char* lds, int tile, int tid, int lane, int wave) {
    { int tz; asm volatile("v_mov_b32 %0, 0" : "=v"(tz)); tid += tz; lane += tz; }
    constexpr int XST = 0, CM = 69632, BM = 104448, ACUM = 139264, DTS = ACUM + 2048, PSS = DTS + 2048;
    const int g = tile & 3, bc = tile >> 2, c = bc & 31; const size_t grow0 = (size_t)bc * 128;
    unsigned char* ws = a.ws; const bf16* XBC = (const bf16*)(ws + WS_XBC); const float* DT = (const float*)(ws + WS_DT); const bf16* ST = (const bf16*)(ws + WS_ST); bf16* MIX = (bf16*)(ws + WS_MIX);
    const float* cw = a.in[10]; const float* cb = a.in[11]; const float* a_log = a.in[13]; const float* d_skip = a.in[14]; const float* norm_g = a.in[15];
    if (wave < 4) { float a0, a1, d0, d1; (void)ssd_scan(DT, a_log, grow0, g * 4 + wave, wave, lane, (LAS float*)(lds + ACUM), (LAS float*)(lds + DTS), a0, a1, d0, d1); }
    {
        const bool first = (c == 0);
        float o[8][8];
        {
            const int chg = tid & 31, l0 = (tid >> 5) * 8;
            conv8x8(XBC, grow0, l0, first, g * 256 + chg * 8, cw, cb, o);
#pragma unroll
            for (int e = 0; e < 8; ++e) {
                u32x4 w; w.x = pk2(o[0][e], o[1][e]); w.y = pk2(o[2][e], o[3][e]); w.z = pk2(o[4][e], o[5][e]); w.w = pk2(o[6][e], o[7][e]);
                *(LAS u32x4*)(lds + XST + ((chg * 8 + e) * 136 + l0) * 2) = w;
            }
        }
        {
            const int half = tid >> 8, chg = tid & 15, l0 = ((tid >> 4) & 15) * 8;
            conv8x8(XBC, grow0, l0, first, (half ? 1536 : 1024) + g * 128 + chg * 8, cw, cb, o);
            const int dstb = half ? CM : BM;
#pragma unroll
            for (int j = 0; j < 8; ++j) {
                u32x4 w; w.x = pk2(o[j][0], o[j][1]); w.y = pk2(o[j][2], o[j][3]); w.z = pk2(o[j][4], o[j][5]); w.w = pk2(o[j][6], o[j][7]);
                *(LAS u32x4*)(lds + dstb + ((l0 + j) * 136 + chg * 8) * 2) = w;
            }
        }
    }
    __syncthreads();
    const int lr = lane & 15, q = lane >> 4;
    const int r = wave >> 1, lh = wave & 1, h = g * 4 + r;
    bf16x8 pv[4][4];
    {
        const bf16* prev = ST + ((size_t)bc * 16 + h) * 8192;
#pragma unroll
        for (int ks = 0; ks < 4; ++ks)
#pragma unroll
            for (int nt = 0; nt < 4; ++nt) pv[ks][nt] = *(const bf16x8*)(prev + (nt * 16 + lr) * 128 + ks * 32 + q * 8);
    }
    {
        const int wr4 = wave >> 1, wc2 = wave & 1;
        f32x4 cbv[2][4];
#pragma unroll
        for (int mt = 0; mt < 2; ++mt)
#pragma unroll
            for (int nt = 0; nt < 4; ++nt) cbv[mt][nt] = (f32x4){0.f, 0.f, 0.f, 0.f};
#pragma unroll
        for (int ks = 0; ks < 4; ++ks) {
            bf16x8 af[2];
#pragma unroll
            for (int mt = 0; mt < 2; ++mt) af[mt] = lds128(lds, CM + ((wr4 * 32 + mt * 16 + lr) * 136 + ks * 32 + q * 8) * 2);
#pragma unroll
            for (int nt = 0; nt < 4; ++nt) {
                const bf16x8 bfr = lds128(lds, BM + ((wc2 * 64 + nt * 16 + lr) * 136 + ks * 32 + q * 8) * 2);
#pragma unroll
                for (int mt = 0; mt < 2; ++mt) cbv[mt][nt] = mma(cbv[mt][nt], af[mt], bfr);
            }
        }
        __syncthreads();
#pragma unroll
        for (int mt = 0; mt < 2; ++mt)
#pragma unroll
            for (int nt = 0; nt < 4; ++nt) {
                u32x2 w; w.x = pk2(cbv[mt][nt][0], cbv[mt][nt][1]); w.y = pk2(cbv[mt][nt][2], cbv[mt][nt][3]);
                *(LAS u32x2*)(lds + BM + ((wr4 * 32 + mt * 16 + lr) * 136 + wc2 * 64 + nt * 16 + q * 4) * 2) = w;
            }
        __syncthreads();
    }
    const LAS float* acum = (const LAS float*)(lds + ACUM) + r * 128; const LAS float* dts = (const LAS float*)(lds + DTS) + r * 128;
    f32x4 acc[4][4];
#pragma unroll
    for (int mt = 0; mt < 4; ++mt)
#pragma unroll
        for (int nt = 0; nt < 4; ++nt) acc[mt][nt] = (f32x4){0.f, 0.f, 0.f, 0.f};
    {
#pragma unroll
        for (int ks = 0; ks < 4; ++ks) {
            bf16x8 af[4];
#pragma unroll
            for (int mt = 0; mt < 4; ++mt) af[mt] = lds128(lds, CM + ((lh * 64 + mt * 16 + lr) * 136 + ks * 32 + q * 8) * 2);
#pragma unroll
            for (int nt = 0; nt < 4; ++nt)
#pragma unroll
                for (int mt = 0; mt < 4; ++mt) acc[mt][nt] = mma(acc[mt][nt], af[mt], pv[ks][nt]);
        }
    }
    float al[4];
#pragma unroll
    for (int mt = 0; mt < 4; ++mt) { al[mt] = acum[lh * 64 + mt * 16 + lr]; const float sc = ex(al[mt]);
#pragma unroll
        for (int nt = 0; nt < 4; ++nt) acc[mt][nt] = acc[mt][nt] * sc; }
#pragma unroll 1
    for (int ks = 0; ks <= lh * 2 + 1; ++ks) {
        const int s0 = ks * 32 + q * 8;
        const f32x4 as0 = *(const LAS f32x4*)(acum + s0), as1 = *(const LAS f32x4*)(acum + s0 + 4), dd0 = *(const LAS f32x4*)(dts + s0), dd1 = *(const LAS f32x4*)(dts + s0 + 4);
        bf16x8 bx[4];
#pragma unroll
        for (int nt = 0; nt < 4; ++nt) bx[nt] = lds128(lds, XST + ((r * 64 + nt * 16 + lr) * 136 + s0) * 2);
#pragma unroll
        for (int mt = 0; mt < 4; ++mt) {
            if (lh * 64 + mt * 16 + 15 < ks * 32) continue;
            const int l = lh * 64 + mt * 16 + lr;
            const u32x4 raw = *(const LAS u32x4*)(lds + BM + (l * 136 + s0) * 2);
            float w[8];
            w[0] = bflo(raw.x); w[1] = bfhi(raw.x); w[2] = bflo(raw.y); w[3] = bfhi(raw.y); w[4] = bflo(raw.z); w[5] = bfhi(raw.z); w[6] = bflo(raw.w); w[7] = bfhi(raw.w);
#pragma unroll
            for (int e = 0; e < 8; ++e) {
                const float as = e < 4 ? as0[e & 3] : as1[e & 3], dd = e < 4 ? dd0[e & 3] : dd1[e & 3];
                const bool valid = (s0 + e) <= l;
                const float arg = valid ? (al[mt] - as) : 0.f;
                w[e] = valid ? w[e] * ex(arg) * dd : 0.f;
            }
            u32x4 pw; pw.x = pk2(w[0], w[1]); pw.y = pk2(w[2], w[3]); pw.z = pk2(w[4], w[5]); pw.w = pk2(w[6], w[7]);
            const bf16x8 af = __builtin_bit_cast(bf16x8, pw);
#pragma unroll
            for (int nt = 0; nt < 4; ++nt) acc[mt][nt] = mma(acc[mt][nt], af, bx[nt]);
        }
    }
    const float dsk = d_skip[h];
#pragma unroll
    for (int mt = 0; mt < 4; ++mt) {
        const int l = lh * 64 + mt * 16 + lr; float ssq = 0.f;
#pragma unroll
        for (int nt = 0; nt < 4; ++nt) {
            const int ch = r * 64 + nt * 16 + q * 4;
            const u32x2 zz = *(const u32x2*)(MIX + (grow0 + l) * 2048 + 1024 + g * 256 + ch);
            float xs[4], zf[4];
            zf[0] = bflo(zz.x); zf[1] = bfhi(zz.x); zf[2] = bflo(zz.y); zf[3] = bfhi(zz.y);
#pragma unroll
            for (int j = 0; j < 4; ++j) xs[j] = __uint_as_float(((unsigned)*(const LAS unsigned short*)(lds + XST + ((ch + j) * 136 + l) * 2)) << 16);
#pragma unroll
            for (int j = 0; j < 4; ++j) { const float y = (acc[mt][nt][j] + dsk * xs[j]) * silu(zf[j]); acc[mt][nt][j] = y; ssq += y * y; }
        }
        ssq += __shfl_xor(ssq, 16); ssq += __shfl_xor(ssq, 32);
        if (q == 0) ((LAS float*)(lds + PSS))[r * 128 + l] = ssq;
        __builtin_amdgcn_sched_barrier(0);
    }
    __syncthreads();
#pragma unroll
    for (int mt = 0; mt < 4; ++mt) {
        const int l = lh * 64 + mt * 16 + lr; const LAS float* pss = (const LAS float*)(lds + PSS);
        const float tot = (pss[l] + pss[128 + l]) + (pss[256 + l] + pss[384 + l]);
        const float rs = rsqrtf(tot * (1.f / 256.f) + 1e-5f);
#pragma unroll
        for (int nt = 0; nt < 4; ++nt) {
            const int ch = r * 64 + nt * 16 + q * 4;
            const f32x4 ng = *(const f32x4*)(norm_g + g * 256 + ch);
            u32x2 w; w.x = pk2(acc[mt][nt][0] * rs * ng.x, acc[mt][nt][1] * rs * ng.y); w.y = pk2(acc[mt][nt][2] * rs * ng.z, acc[mt][nt][3] * rs * ng.w);
            *(u32x2*)(MIX + (grow0 + l) * 2048 + 1024 + g * 256 + ch) = w;
        }
        __builtin_amdgcn_sched_barrier(0);
    }
    __syncthreads();
}

__device__ __forceinline__ void attn_tile(const Args& a, LAS unsigned char* lds, int tile, int tid, int lane, int wave) {
    constexpr int KB = 0, VT = 36864;
    const int kvh = tile & 1, bn = tile >> 1, nb = bn & 31;
    const bf16* QKV = (const bf16*)(a.ws + WS_QKV); bf16* ATT = (bf16*)(a.ws + WS_ATT); const float* sinks = a.in[20];
    if (tid < 256) {
        const int d0 = (tid & 7) * 8, s0 = (tid >> 3) * 8;
        u32x4 v[8];
#pragma unroll
        for (int j = 0; j < 8; ++j) { const int sk = s0 + j; v[j] = (u32x4){0u, 0u, 0u, 0u};
            if (nb > 0 || sk >= 128) v[j] = *(const u32x4*)(QKV + ((long)bn * 128 - 128 + sk) * QKVD + 1152 + kvh * 64 + d0); }
#pragma unroll
        for (int e = 0; e < 8; ++e) {
            unsigned hh[8];
#pragma unroll
            for (int j = 0; j < 8; ++j) { const unsigned wd = v[j][e >> 1]; hh[j] = (e & 1) ? (wd >> 16) : (wd & 0xffffu); }
            u32x4 w; w.x = hh[0] | (hh[1] << 16); w.y = hh[2] | (hh[3] << 16); w.z = hh[4] | (hh[5] << 16); w.w = hh[6] | (hh[7] << 16);
            *(LAS u32x4*)(lds + VT + (slot32(d0 + e) * 264 + s0) * 2) = w;
        }
    } else {
        const int t2 = tid - 256;
#pragma unroll
        for (int i = 0; i < 8; ++i) {
            const int p = t2 + 256 * i, sk = p >> 3, pc = p & 7;
            u32x4 kv = {0u, 0u, 0u, 0u};
            if (nb > 0 || sk >= 128) kv = *(const u32x4*)(QKV + ((long)bn * 128 - 128 + sk) * QKVD + 1024 + kvh * 64 + pc * 8);
            *(LAS u32x4*)(lds + KB + (sk * 72 + pc * 8) * 2) = kv;
        }
    }
    __syncthreads();
    const int h = kvh * 8 + wave, lr = lane & 15, q4 = lane >> 4; const float sink = sinks[h];
    bf16x8 aqn[2];
#pragma unroll
    for (int ks = 0; ks < 2; ++ks) aqn[ks] = *(const bf16x8*)(QKV + ((size_t)bn * 128 + lr) * QKVD + h * 64 + ks * 32 + q4 * 8);
#pragma unroll 1
    for (int qc = 0; qc < 8; ++qc) {
        const int qi = qc * 16 + lr; const size_t qrow = (size_t)bn * 128 + qi;
        bf16x8 aq[2];
#pragma unroll
        for (int ks = 0; ks < 2; ++ks) aq[ks] = aqn[ks];
        { const size_t qnext = qrow + (qc < 7 ? 16 : 0);
#pragma unroll
          for (int ks = 0; ks < 2; ++ks) aqn[ks] = *(const bf16x8*)(QKV + qnext * QKVD + h * 64 + ks * 32 + q4 * 8); }
        f32x4 sc[10];
#pragma unroll
        for (int t = 0; t < 9; ++t) {
            sc[t] = (f32x4){0.f, 0.f, 0.f, 0.f};
#pragma unroll
            for (int ks = 0; ks < 2; ++ks) sc[t] = mma(sc[t], aq[ks], lds128(lds, KB + (((qc + t) * 16 + lr) * 72 + ks * 32 + q4 * 8) * 2));
        }
        sc[9] = (f32x4){0.f, 0.f, 0.f, 0.f};
        float m = sink;
#pragma unroll
        for (int t = 0; t < 9; ++t)
#pragma unroll
            for (int j = 0; j < 4; ++j) {
                const int si = (qc + t) * 16 + q4 * 4 + j;
                const bool valid = (si >= qi + 1) && (si <= qi + 128) && (nb > 0 || si >= 128);
                const float v = valid ? sc[t][j] * 0.125f : -INFINITY;
                sc[t][j] = v; m = fmaxf(m, v);
            }
        m = fmaxf(m, __shfl_xor(m, 16)); m = fmaxf(m, __shfl_xor(m, 32));
        float sum = 0.f;
#pragma unroll
        for (int t = 0; t < 9; ++t)
#pragma unroll
            for (int j = 0; j < 4; ++j) { const float p = ex(sc[t][j] - m); sc[t][j] = p; sum += p; }
        sum += __shfl_xor(sum, 16); sum += __shfl_xor(sum, 32);
        const float inv = 1.f / (sum + ex(sink - m));
        f32x4 o[4];
#pragma unroll
        for (int dt = 0; dt < 4; ++dt) o[dt] = (f32x4){0.f, 0.f, 0.f, 0.f};
#pragma unroll
        for (int kk = 0; kk < 5; ++kk) {
            const int t0 = 2 * kk, t1 = 2 * kk + 1;
            u32x4 pw; pw.x = pk2(sc[t0][0], sc[t0][1]); pw.y = pk2(sc[t0][2], sc[t0][3]); pw.z = pk2(sc[t1][0], sc[t1][1]); pw.w = pk2(sc[t1][2], sc[t1][3]);
            const bf16x8 af = __builtin_bit_cast(bf16x8, pw);
            const int T0 = qc + t0, T1 = (qc + t1) > 15 ? 15 : (qc + t1);
#pragma unroll
            for (int dt = 0; dt < 4; ++dt) {
                const u32x2 b0 = *(const LAS u32x2*)(lds + VT + ((dt * 16 + lr) * 264 + T0 * 16 + q4 * 4) * 2), b1 = *(const LAS u32x2*)(lds + VT + ((dt * 16 + lr) * 264 + T1 * 16 + q4 * 4) * 2);
                u32x4 bw; bw.x = b0.x; bw.y = b0.y; bw.z = b1.x; bw.w = b1.y;
                o[dt] = mma(o[dt], af, __builtin_bit_cast(bf16x8, bw));
            }
        }
#pragma unroll
        for (int G2 = 0; G2 < 2; ++G2) {
            u32x4 w; w.x = pk2(o[2 * G2][0] * inv, o[2 * G2][1] * inv); w.y = pk2(o[2 * G2][2] * inv, o[2 * G2][3] * inv);
            w.z = pk2(o[2 * G2 + 1][0] * inv, o[2 * G2 + 1][1] * inv); w.w = pk2(o[2 * G2 + 1][2] * inv, o[2 * G2 + 1][3] * inv);
            *(u32x4*)(ATT + qrow * 1024 + h * 64 + G2 * 32 + q4 * 8) = w;
        }
    }
    __syncthreads();
}

__device__ __forceinline__ float wave_sum(float v) {
#pragma unroll
    for (int o = 1; o < 64; o <<= 1) v += __shfl_xor(v, o);
    return v;
}

#define XB_TMO      128
#define XB_XCNT(j)  (256  + 64 * (j))
#define XB_XSUB(j)  (1280 + 64 * (j))
#define XB_XGEN(j)  (2304 + 64 * (j))
#define XB_TOP      3328
#define XB_TOPGEN   3392
#define XCD_BAR_WORDS 3456
#define XB_SPIN_CAP (1u << 18)

__device__ __forceinline__ unsigned xb_ld(unsigned* p)              { return __hip_atomic_load(p, __ATOMIC_RELAXED, __HIP_MEMORY_SCOPE_AGENT); }
__device__ __forceinline__ unsigned xb_add(unsigned* p, unsigned v) { return __hip_atomic_fetch_add(p, v, __ATOMIC_RELAXED, __HIP_MEMORY_SCOPE_AGENT); }
__device__ __forceinline__ unsigned xb_xcc_id() { return (unsigned)__builtin_amdgcn_s_getreg((3 << 11) | 20) & 0xFu; }
#define XB_SPIN(cond, bar) do { unsigned _sp = 0; while (cond) { __builtin_amdgcn_s_sleep(1); \
    if ((++_sp & 255u) == 0u) { if (xb_ld(&(bar)[XB_TMO])) break; if (_sp > XB_SPIN_CAP) { atomicAdd(&(bar)[XB_TMO], 1u); break; } } } } while (0)

struct XcdBarrier {
    unsigned* bar; unsigned x;
    volatile LAS unsigned* st;
};

__device__ __forceinline__ XcdBarrier xcd_barrier_post(unsigned* bar, volatile LAS unsigned* st) {
    XcdBarrier b; b.bar = bar; b.x = xb_xcc_id(); b.st = st;
    if (threadIdx.x == 0) (void)xb_add(&bar[XB_XCNT(b.x)], 1u);
    return b;
}
__device__ __forceinline__ void xcd_barrier_complete(unsigned* bar, unsigned x, unsigned& nloc, unsigned& nx) {
    const unsigned G = gridDim.x * gridDim.y * gridDim.z;
    unsigned sum, cnt, mine, sp = 0u;
    for (;;) {
        sum = 0u; cnt = 0u; mine = 0u;
#pragma unroll
        for (unsigned j = 0; j < 16; ++j) { const unsigned c = xb_ld(&bar[XB_XCNT(j)]); sum += c; cnt += (c > 0u) ? 1u : 0u; mine = (j == x) ? c : mine; }
        if (sum == G) break;
        __builtin_amdgcn_s_sleep(1);
        if ((++sp & 255u) == 0u) { if (xb_ld(&bar[XB_TMO])) break; if (sp > XB_SPIN_CAP) { atomicAdd(&bar[XB_TMO], 1u); break; } }
    }
    nloc = mine > 0u ? mine : 1u; nx = cnt > 0u ? cnt : 1u;
}

__device__ __forceinline__ void xcd_barrier(const XcdBarrier& b) {
    asm volatile("s_waitcnt vmcnt(0)" ::: "memory");
    __syncthreads();
    if (threadIdx.x == 0) {
        unsigned* bar = b.bar;
        __builtin_amdgcn_s_waitcnt(0);
        unsigned nloc = b.st[0], nx = b.st[1];
        if (nloc == 0u) { xcd_barrier_complete(bar, b.x, nloc, nx); b.st[0] = nloc; b.st[1] = nx; }
        const unsigned old = xb_add(&bar[XB_XSUB(b.x)], 1u);
        const unsigned gen = old / nloc;
        if (old + 1u == (gen + 1u) * nloc) {
            __builtin_amdgcn_fence(__ATOMIC_RELEASE, "agent");
            asm volatile("s_waitcnt vmcnt(0)" ::: "memory");
            const unsigned og = xb_add(&bar[XB_TOP], 1u);
            const unsigned tg = og / nx;
            if (og + 1u == (tg + 1u) * nx) xb_add(&bar[XB_TOPGEN], 1u);
            else XB_SPIN(xb_ld(&bar[XB_TOPGEN]) == tg, bar);
            __builtin_amdgcn_fence(__ATOMIC_ACQUIRE, "agent");
            xb_add(&bar[XB_XGEN(b.x)], 1u);
            asm volatile("s_waitcnt vmcnt(0)" ::: "memory");
        } else {
            XB_SPIN(xb_ld(&bar[XB_XGEN(b.x)]) == gen, bar);
            __builtin_amdgcn_fence(__ATOMIC_ACQUIRE, "agent");
            asm volatile("s_waitcnt vmcnt(0)" ::: "memory");
        }
    }
    __syncthreads();
}

__global__ void __launch_bounds__(512, 2) hybrid_fwd(Args args) {
    extern __shared__ __attribute__((aligned(16))) unsigned char lds_raw[];
    LAS unsigned char* lds = (LAS unsigned char*)lds_raw;
    const int tid = threadIdx.x, lane = tid & 63, wave = __builtin_amdgcn_readfirstlane(tid >> 6), G = gridDim.x;
    unsigned char* ws = args.ws;
    const int lo = args.ph_lo, hi = args.ph_hi;
    cg::grid_group grid = cg::this_grid();
    if (lo > hi) grid.sync();
    volatile LAS unsigned* bst = (volatile LAS unsigned*)(lds + LDS_BYTES - 16);
    if (tid < 4) bst[tid] = 0u;
    __syncthreads();
    XcdBarrier bar = xcd_barrier_post((unsigned*)ws, bst);
#ifndef PH_MASK
#define PH_MASK 0x3fff
#endif
#define IN(k) (((PH_MASK >> (k)) & 1) && lo <= (k) && (k) < hi)
#define SEAM(k) do { if (IN(k) && IN((k) + 1)) { xcd_barrier(bar); } } while (0)
    bf16* XB = (bf16*)(ws + WS_XB); float* SSP = (float*)(ws + WS_SSP); float* H = args.out;

    if (IN(0)) { phase0(args, lds, tid, lane, wave, G); } SEAM(0);
    if (IN(1)) {
        pg8::Gemm g{XB, (const bf16*)(ws + WS_WIN), MTOK, NPROJ, DM}; pg8::StaticOrder S; S.init(MTOK, NPROJ, G, (int)blockIdx.x);
        EpiInProj E{SSP, (bf16*)(ws + WS_MIX), (bf16*)(ws + WS_GV), (bf16*)(ws + WS_XBC), (float*)(ws + WS_LNP)};
        pg8::gemm_phase<EpiInProj, pg8::StaticOrder, true, true>(lds, g, S, E);
    } SEAM(1);
    if (IN(2)) {
        for (int t = blockIdx.x; t < 1024 + 2048; t += G) { if (t < 1024) ssd_a_tile(args, lds, t, tid, lane, wave); else gmlp_tile(args, lds, t - 1024, tid, lane, wave); }
    } SEAM(2);
    if (IN(3)) { scan_phase(args, tid, G); } SEAM(3);
    if (IN(4)) { for (int t = blockIdx.x; t < 1024; t += G) ssd_b_tile(args, lds, t, tid, lane, wave); } SEAM(4);
    if (IN(5)) {
        pg8::Gemm g{(const bf16*)(ws + WS_MIX), (const bf16*)(ws + WS_WOUT), MTOK, DM, 2048}; pg8::StaticOrder S; S.init(MTOK, DM, G, (int)blockIdx.x);
        EpiResid E{XB, SSP, nullptr};
        pg8::gemm_phase<EpiResid, pg8::StaticOrder, true, true>(lds, g, S, E);
    } SEAM(5);
    if (IN(6)) {
        pg8::Gemm g{XB, (const bf16*)(ws + WS_WUP0), MTOK, DFF, DM}; pg8::StaticOrder S; S.init(MTOK, DFF, G, (int)blockIdx.x);
        EpiRelu2 E{SSP, (bf16*)(ws + WS_HID)};
        pg8::gemm_phase<EpiRelu2, pg8::StaticOrder, true, true>(lds, g, S, E);
    } SEAM(6);
    if (IN(7)) {
        pg8::Gemm g{(const bf16*)(ws + WS_HID), (const bf16*)(ws + WS_WDN0), MTOK, DM, DFF, HIDP}; pg8::StaticOrder S; S.init(MTOK, DM, G, (int)blockIdx.x);
        EpiResid E{XB, SSP, nullptr};
        pg8::gemm_phase<EpiResid, pg8::StaticOrder, true, true>(lds, g, S, E);
    } SEAM(7);
    if (IN(8)) {
        pg8::Gemm g{XB, (const bf16*)(ws + WS_WQKV), MTOK, QKVD, DM}; pg8::StaticOrder S; S.init(MTOK, QKVD, G, (int)blockIdx.x);
        EpiQKV E{SSP, (bf16*)(ws + WS_QKV), args.in[17]};
        pg8::gemm_phase<EpiQKV, pg8::StaticOrder, true, true>(lds, g, S, E);
    } SEAM(8);
    if (IN(9)) { for (int t = blockIdx.x; t < 512; t += G) attn_tile(args, lds, t, tid, lane, wave); } SEAM(9);
    if (IN(10)) {
        pg8::Gemm g{(const bf16*)(ws + WS_ATT), (const bf16*)(ws + WS_WO), MTOK, DM, DM}; pg8::StaticOrder S; S.init(MTOK, DM, G, (int)blockIdx.x);
        EpiResid E{XB, SSP, args.in[19]};
        pg8::gemm_phase<EpiResid, pg8::StaticOrder, true, true>(lds, g, S, E);
    } SEAM(10);
    if (IN(11)) {
        pg8::Gemm g{XB, (const bf16*)(ws + WS_WUP1), MTOK, DFF, DM}; pg8::StaticOrder S; S.init(MTOK, DFF, G, (int)blockIdx.x);
        EpiRelu2 E{SSP, (bf16*)(ws + WS_HID)};
        pg8::gemm_phase<EpiRelu2, pg8::StaticOrder, true, true>(lds, g, S, E);
    } SEAM(11);
    if (IN(12)) {
        pg8::Gemm g{(const bf16*)(ws + WS_HID), (const bf16*)(ws + WS_WDN1), MTOK, DM, DFF, HIDP}; pg8::StaticOrder S; S.init(MTOK, DM, G, (int)blockIdx.x);
        EpiResid E{XB, SSP, nullptr};
        pg8::gemm_phase<EpiResid, pg8::StaticOrder, true, true>(lds, g, S, E);
    } SEAM(12);
    if (IN(13)) {
        const float* fg = args.in[3];
        f32x4 gv[2][2];
#pragma unroll
        for (int j = 0; j < 2; ++j) { gv[j][0] = *(const f32x4*)(fg + j * 512 + lane * 8); gv[j][1] = *(const f32x4*)(fg + j * 512 + lane * 8 + 4); }
        for (int m = blockIdx.x * 8 + wave; m < MTOK; m += G * 8) {
            f32x4 v[2][2]; float sq = 0.f;
#pragma unroll
            for (int j = 0; j < 2; ++j) { const u32x4 r = *(const u32x4*)(XB + (size_t)m * DM + j * 512 + lane * 8);
                v[j][0] = (f32x4){bflo(r.x), bfhi(r.x), bflo(r.y), bfhi(r.y)}; v[j][1] = (f32x4){bflo(r.z), bfhi(r.z), bflo(r.w), bfhi(r.w)};
#pragma unroll
                for (int k = 0; k < 2; ++k) sq += (v[j][k].x * v[j][k].x + v[j][k].y * v[j][k].y) + (v[j][k].z * v[j][k].z + v[j][k].w * v[j][k].w); }
            const float rs = rsqrtf(wave_sum(sq) * (1.f / 1024.f) + 1e-5f);
#pragma unroll
            for (int j = 0; j < 2; ++j)
#pragma unroll
                for (int k = 0; k < 2; ++k) *(f32x4*)(H + (size_t)m * DM + j * 512 + lane * 8 + k * 4) = v[j][k] * rs * gv[j][k];
        }
    }
#ifdef DBG_STOP
    if (lo == 100) {
        const unsigned short* base = (const unsigned short*)(ws + (size_t)DBG_LO * MiB); const size_t n = (size_t)(DBG_HI - DBG_LO) * MiB / 2;
        for (size_t i = (size_t)blockIdx.x * 512 + tid; i < (size_t)MTOK * DM; i += (size_t)G * 512) { float sum = 0.f; for (size_t e = i; e < n; e += (size_t)MTOK * DM) sum += (float)base[e]; args.out[i] = sum; }
    }
#endif
#undef IN
#undef SEAM
}

#ifndef MK_N_LAUNCHES
#define MK_N_LAUNCHES 14
#endif

__global__ void dbg_fill(float* o, size_t n, float v) { for (size_t i = (size_t)blockIdx.x * 256 + threadIdx.x; i < n; i += (size_t)gridDim.x * 256) o[i] = v; }
extern "C" void kernel_launch(void* const* d_in, const int* in_sizes, int n_in, void* d_out, int out_size, void* d_ws, size_t ws_size, hipStream_t stream) {
    static int grid = 0;
    if (grid == 0) {
        if (n_in != 23 || in_sizes[0] != MTOK * DM || out_size != MTOK * DM || ws_size < WS_END) {
            fprintf(stderr, "kernel_launch: unexpected shapes: n_in %d in0 %d out %d ws %zu (need %zu)\n", n_in, n_in > 0 ? in_sizes[0] : -1, out_size, ws_size, (size_t)WS_END); grid = -1; return; }
        int dev = 0, cus = 0, per_cu = 0;
        if (hipGetDevice(&dev) != hipSuccess || hipDeviceGetAttribute(&cus, hipDeviceAttributeMultiprocessorCount, dev) != hipSuccess) { fprintf(stderr, "kernel_launch: device query failed\n"); grid = -1; return; }
        if (hipFuncSetAttribute((const void*)hybrid_fwd, hipFuncAttributeMaxDynamicSharedMemorySize, LDS_BYTES) != hipSuccess) { fprintf(stderr, "kernel_launch: hipFuncSetAttribute failed\n"); grid = -1; return; }
        if (hipOccupancyMaxActiveBlocksPerMultiprocessor(&per_cu, (const void*)hybrid_fwd, 512, LDS_BYTES) != hipSuccess || per_cu < 1) { fprintf(stderr, "kernel_launch: occupancy query says %d\n", per_cu); per_cu = 1; }
        (void)hipGetLastError();
        grid = cus * per_cu;
    }
    if (grid < 0) return;
    if (hipMemsetAsync(d_ws, 0, 16384, stream) != hipSuccess) { fprintf(stderr, "kernel_launch: memset failed\n"); return; }
    Args a{};
    for (int i = 0; i < 23; ++i) a.in[i] = (const float*)d_in[i];
    a.out = (float*)d_out; a.ws = (unsigned char*)d_ws;
#if MK_N_LAUNCHES == 1
    a.ph_lo = 0; a.ph_hi = NPHASE;
    void* kargs[] = {&a};
    hipError_t e = hipLaunchCooperativeKernel((const void*)hybrid_fwd, dim3(grid), dim3(512), kargs, LDS_BYTES, stream);
    if (e != hipSuccess) fprintf(stderr, "kernel_launch: cooperative launch failed: %s (grid %d)\n", hipGetErrorString(e), grid);
#else
#ifdef DBG_STOP
    for (int p = 0; p <= DBG_STOP; ++p) { a.ph_lo = p; a.ph_hi = p + 1; hipLaunchKernelGGL(hybrid_fwd, dim3(grid), dim3(512), LDS_BYTES, stream, a); }
    if (DBG_HI > DBG_LO) { a.ph_lo = 100; a.ph_hi = 101; hipLaunchKernelGGL(hybrid_fwd, dim3(grid), dim3(512), LDS_BYTES, stream, a); }
#else
    for (int p = 0; p < NPHASE; ++p) { a.ph_lo = p; a.ph_hi = p + 1; hipLaunchKernelGGL(hybrid_fwd, dim3(grid), dim3(512), LDS_BYTES, stream, a); }
#endif
#endif
}
```

```cpp
#define MK_N_LAUNCHES 1
#include <hip/hip_runtime.h>
#include <hip/hip_cooperative_groups.h>
#include <cstdio>
#include <cstdint>
namespace cg = cooperative_groups;
namespace pg8 {
#define PG8_LAS __attribute__((address_space(3)))
typedef unsigned short bf16_t;
typedef short bf16x8 __attribute__((ext_vector_type(8)));
typedef float f32x4 __attribute__((ext_vector_type(4)));
typedef unsigned u32x4 __attribute__((ext_vector_type(4)));
constexpr int BM = 256, BK = 64, HALF = 128, HTB = HALF * BK * 2  , STAGE_BYTES = 8 * HTB, NXCD = 8, WGM = 8;

__host__ __device__ __forceinline__ int lds_byte(int r, int c) { const int st = (r >> 4) * 2 + (c >> 5), rr = r & 15, cc = c & 31, ob = rr * 64 + cc * 2; return st * 1024 + (ob ^ (((ob >> 9) & 1) << 5)); }
__host__ __device__ __forceinline__ void stage_rc(int b, int& R, int& C) { const int st = b / 1024, sb = b % 1024, swz = sb ^ (((sb >> 9) & 1) << 5); R = (st >> 1) * 16 + swz / 64; C = (st & 1) * 32 + (swz % 64) / 2; }
__host__ __device__ __forceinline__ int perm32(int rho) { const int n = rho >> 4, i = rho & 15; return 8 * (i >> 2) + 4 * n + (i & 3); }

struct Unit { int pm, pn; };
struct Gemm { const bf16_t* A; const bf16_t* Bt; int M, N, K; int lda; };

struct StaticOrder {
    int nM, nN, nwg, G, c;
    __host__ __device__ void init(int M, int N, int G_, int c_) { nM = M / BM; nN = N / BM; nwg = nM * nN; G = G_; c = c_; }
    __host__ __device__ bool next(int i, Unit& u) const {
        const long L = (long)i * G + c; if (L >= nwg) return false;
        int wgid = (int)L; { const int q = nwg / NXCD, r = nwg % NXCD, xcd = wgid % NXCD, off = wgid / NXCD; wgid = (xcd < r ? xcd * (q + 1) : r * (q + 1) + (xcd - r) * q) + off; }
        const int nig = WGM * nN, gid = wgid / nig, fm = gid * WGM, gsz = (nM - fm) < WGM ? (nM - fm) : WGM;
        u.pm = fm + ((wgid % nig) % gsz); u.pn = (wgid % nig) / gsz; return true;
    }
    __device__ __forceinline__ void a_ready(const Unit&) const {}
    __device__ __forceinline__ void done(const Unit&) const {}
};

__device__ __forceinline__ unsigned cvt_pk_bf16(float lo, float hi) { unsigned r; asm volatile("v_cvt_pk_bf16_f32 %0, %1, %2" : "=v"(r) : "v"(lo), "v"(hi)); return r; }
typedef float f32x2 __attribute__((ext_vector_type(2)));
template <class Epi, class Sched, bool ALIGN_EPI = false, bool SP2 = false>
__device__ __forceinline__ void gemm_phase(PG8_LAS unsigned char* lds, const Gemm g, const Sched& S, const Epi& E) {
    const int tid = threadIdx.x, wid = __builtin_amdgcn_readfirstlane(tid >> 6), lane = tid & 63, wr = wid >> 2, wc = wid & 3, fr = lane & 15, fq = lane >> 4;
    const int K = g.K, nt = K / BK, lda = g.lda ? g.lda : g.K;
    unsigned voffA[2], voffB[2];
#pragma unroll
    for (int i = 0; i < 2; ++i) { int R, C; stage_rc(tid * 16 + i * 8192, R, C); const int Rb = Epi::PERM ? ((R & ~31) + perm32(R & 31)) : R;
        voffA[i] = (unsigned)(R * lda + C) * 2u; voffB[i] = (unsigned)(Rb * K + C) * 2u; }
    const size_t kstep = (size_t)(BK * 2);
    const size_t hstep = (size_t)HALF * K * 2;
    const size_t tstep = 2 * hstep; const size_t hstepA = (size_t)HALF * lda * 2, tstepA = 2 * hstepA;
    const unsigned ldsw = (unsigned)wid * 1024u;
    const int aoff = lds_byte(wr * 64 + fr, fq * 8), boff = lds_byte(wc * 32 + fr, fq * 8);
#define PG8_SA(b, h) (((b) * 2 + (h)) * HTB)
#define PG8_SB(b, h) ((4 + (b) * 2 + (h)) * HTB)
#define PG8_STAGE(bufoff, gbase, voff) do { _Pragma("unroll") for (int _i = 0; _i < 2; ++_i) \
        __builtin_amdgcn_global_load_lds((const unsigned*)((const char*)(gbase) + (voff)[_i]), (PG8_LAS unsigned*)(lds + (bufoff) + ldsw + _i * 8192), 16, 0, 0); } while (0)
#define PG8_LDA(dst, b, h) do { _Pragma("unroll") for (int m = 0; m < 4; ++m) _Pragma("unroll") for (int k = 0; k < 2; ++k) dst[m][k] = *(const PG8_LAS bf16x8*)(lds + PG8_SA(b, h) + aoff + m * 2048 + k * 1024); } while (0)
#define PG8_LDB(dst, b, h) do { _Pragma("unroll") for (int n = 0; n < 2; ++n) _Pragma("unroll") for (int k = 0; k < 2; ++k) dst[n][k] = *(const PG8_LAS bf16x8*)(lds + PG8_SB(b, h) + boff + n * 2048 + k * 1024); } while (0)
#define PG8_MMA(ai, bj, At, Bt) do { __builtin_amdgcn_s_setprio(1); _Pragma("unroll") for (int m = 0; m < 4; ++m) _Pragma("unroll") for (int n = 0; n < 2; ++n) _Pragma("unroll") for (int k = 0; k < 2; ++k) \
        acc[ai][bj][m][n] = __builtin_amdgcn_mfma_f32_16x16x32_bf16(Bt[n][k], At[m][k], acc[ai][bj][m][n], 0, 0, 0); __builtin_amdgcn_s_setprio(0); } while (0)
#define PG8_WAIT_V(n) asm volatile("s_waitcnt vmcnt(" #n ")" ::: "memory")
#define PG8_WAIT_L(n) asm volatile("s_waitcnt lgkmcnt(" #n ")" ::: "memory")
#define PG8_BAR __builtin_amdgcn_s_barrier()
#define PG8_SCHED __builtin_amdgcn_sched_barrier(0)
    Unit cur, nxt; int ui = 0;
    if (!S.next(0, cur)) return;
    f32x4 acc[2][2][4][2];
#pragma unroll
    for (int a = 0; a < 2; ++a)
#pragma unroll
        for (int b = 0; b < 2; ++b)
#pragma unroll
            for (int m = 0; m < 4; ++m)
#pragma unroll
                for (int n = 0; n < 2; ++n) acc[a][b][m][n] = (f32x4){0.f, 0.f, 0.f, 0.f};
    bf16x8 At[4][2], B0[2][2], B1[2][2];
    const char* cA = (const char*)g.A + (size_t)cur.pm * tstepA; const char* cB = (const char*)g.Bt + (size_t)cur.pn * tstep;
    S.a_ready(cur);
    if constexpr (SP2) {
        PG8_STAGE(PG8_SB(0, 0), cB, voffB); PG8_STAGE(PG8_SB(0, 1), cB + hstep, voffB); PG8_STAGE(PG8_SA(0, 0), cA, voffA); PG8_STAGE(PG8_SA(0, 1), cA + hstepA, voffA);
        if (wr == 1) PG8_BAR;
        PG8_WAIT_V(2); PG8_BAR;
        PG8_STAGE(PG8_SB(1, 0), cB + kstep, voffB); PG8_STAGE(PG8_SA(1, 0), cA + kstep, voffA); PG8_STAGE(PG8_SB(1, 1), cB + hstep + kstep, voffB);
        PG8_WAIT_V(6); PG8_BAR;
    } else {
        PG8_STAGE(PG8_SB(0, 0), cB, voffB); PG8_STAGE(PG8_SA(0, 0), cA, voffA); PG8_STAGE(PG8_SB(0, 1), cB + hstep, voffB); PG8_STAGE(PG8_SA(0, 1), cA + hstepA, voffA);
        if (wr == 1) PG8_BAR;
        PG8_WAIT_V(4); PG8_BAR;
        PG8_STAGE(PG8_SB(1, 0), cB + kstep, voffB); PG8_STAGE(PG8_SA(1, 0), cA + kstep, voffA); PG8_STAGE(PG8_SB(1, 1), cB + hstep + kstep, voffB);
        PG8_WAIT_V(6); PG8_BAR;
    }
    for (;;) {
        const bool has_next = S.next(ui + 1, nxt);
        const char* nA = has_next ? (const char*)g.A + (size_t)nxt.pm * tstepA : cA; const char* nB = has_next ? (const char*)g.Bt + (size_t)nxt.pn * tstep : cB;
        for (int t = 0; t < nt; t += 2) {
            const bool last = (t == nt - 2);
            const char* a1 = cA + (size_t)(t + 1) * kstep;
            const char* a2 = last ? nA : cA + (size_t)(t + 2) * kstep; const char* b2 = last ? nB : cB + (size_t)(t + 2) * kstep;
            const char* a3 = a2 + kstep; const char* b3 = b2 + kstep;
            if (last && has_next) S.a_ready(nxt);
            if constexpr (SP2) {
            PG8_LDB(B0, 0, 0); PG8_LDB(B1, 0, 1); PG8_SCHED; PG8_LDA(At, 0, 0); PG8_STAGE(PG8_SA(1, 1), a1 + hstepA, voffA);
            PG8_WAIT_V(8); PG8_WAIT_L(0); PG8_BAR; PG8_MMA(0, 0, At, B0); PG8_MMA(0, 1, At, B1); PG8_BAR; PG8_SCHED;
            PG8_LDA(At, 0, 1); PG8_STAGE(PG8_SB(0, 0), b2, voffB); PG8_STAGE(PG8_SB(0, 1), b2 + hstep, voffB); PG8_STAGE(PG8_SA(0, 0), a2, voffA);
            PG8_WAIT_V(8); PG8_WAIT_L(0); PG8_BAR; PG8_MMA(1, 0, At, B0); PG8_MMA(1, 1, At, B1); PG8_BAR; PG8_SCHED;
            PG8_LDB(B0, 1, 0); PG8_LDB(B1, 1, 1); PG8_SCHED; PG8_LDA(At, 1, 0); PG8_STAGE(PG8_SA(0, 1), a2 + hstepA, voffA);
            PG8_WAIT_V(8); PG8_WAIT_L(0); PG8_BAR; PG8_MMA(0, 0, At, B0); PG8_MMA(0, 1, At, B1); PG8_BAR; PG8_SCHED;
            PG8_LDA(At, 1, 1); PG8_STAGE(PG8_SB(1, 0), b3, voffB); PG8_STAGE(PG8_SB(1, 1), b3 + hstep, voffB); PG8_STAGE(PG8_SA(1, 0), a3, voffA);
            PG8_WAIT_V(8); PG8_WAIT_L(0); PG8_BAR; PG8_MMA(1, 0, At, B0); PG8_MMA(1, 1, At, B1); PG8_BAR; PG8_SCHED;
            } else {
            PG8_LDB(B0, 0, 0); PG8_SCHED; PG8_LDA(At, 0, 0); PG8_STAGE(PG8_SA(1, 1), a1 + hstepA, voffA);
            PG8_WAIT_L(8); PG8_BAR; PG8_WAIT_L(0); PG8_MMA(0, 0, At, B0); PG8_BAR; PG8_SCHED;
            PG8_LDB(B1, 0, 1); PG8_STAGE(PG8_SB(0, 0), b2, voffB);
            PG8_BAR; PG8_WAIT_L(0); PG8_MMA(0, 1, At, B1); PG8_BAR;
            PG8_LDA(At, 0, 1); PG8_STAGE(PG8_SA(0, 0), a2, voffA);
            PG8_BAR; PG8_WAIT_L(0); PG8_MMA(1, 0, At, B0); PG8_BAR; PG8_SCHED;
            PG8_STAGE(PG8_SB(0, 1), b2 + hstep, voffB);
            PG8_WAIT_V(6); PG8_BAR; PG8_MMA(1, 1, At, B1); PG8_BAR;
            PG8_LDB(B0, 1, 0); PG8_SCHED; PG8_LDA(At, 1, 0); PG8_STAGE(PG8_SA(0, 1), a2 + hstepA, voffA);
            PG8_WAIT_L(8); PG8_BAR; PG8_WAIT_L(0); PG8_MMA(0, 0, At, B0); PG8_BAR; PG8_SCHED;
            PG8_LDB(B1, 1, 1); PG8_STAGE(PG8_SB(1, 0), b3, voffB);
            PG8_BAR; PG8_WAIT_L(0); PG8_MMA(0, 1, At, B1); PG8_BAR;
            PG8_LDA(At, 1, 1); PG8_STAGE(PG8_SA(1, 0), a3, voffA);
            PG8_BAR; PG8_WAIT_L(0); PG8_MMA(1, 0, At, B0); PG8_BAR; PG8_SCHED;
            PG8_STAGE(PG8_SB(1, 1), b3 + hstep, voffB);
            PG8_WAIT_V(6); PG8_BAR; PG8_MMA(1, 1, At, B1); PG8_BAR;
            }
        }
        if constexpr (ALIGN_EPI) { if (wr == 0) PG8_BAR; }
        if constexpr (!Epi::AFTER_DRAIN) { E(acc, cur, wr, wc, fr, fq); S.done(cur); }
        if (!has_next) break;
#pragma unroll
        for (int a = 0; a < 2; ++a)
#pragma unroll
            for (int b = 0; b < 2; ++b)
#pragma unroll
                for (int m = 0; m < 4; ++m)
#pragma unroll
                    for (int n = 0; n < 2; ++n) acc[a][b][m][n] = (f32x4){0.f, 0.f, 0.f, 0.f};
        cur = nxt; cA = nA; cB = nB; ++ui;
        if constexpr (ALIGN_EPI) { if (wr == 1) PG8_BAR; }
    }
    PG8_WAIT_V(0);
    if constexpr (!ALIGN_EPI) { if (wr == 0) PG8_BAR; }
    PG8_BAR;
    if constexpr (Epi::AFTER_DRAIN) { E.fused(acc, cur, wr, wc, fr, fq, lds, wid, lane); S.done(cur); }
#undef PG8_SA
#undef PG8_SB
#undef PG8_STAGE
#undef PG8_LDA
#undef PG8_LDB
#undef PG8_MMA
#undef PG8_WAIT_V
#undef PG8_WAIT_L
#undef PG8_BAR
#undef PG8_SCHED
}
}

#define LAS __attribute__((address_space(3)))
typedef unsigned short bf16;
typedef unsigned u32x4 __attribute__((ext_vector_type(4)));
typedef unsigned u32x2 __attribute__((ext_vector_type(2)));
typedef float f32x4 __attribute__((ext_vector_type(4)));
typedef float f32x2 __attribute__((ext_vector_type(2)));
typedef short bf16x8 __attribute__((ext_vector_type(8)));
#define LDS_WAIT() asm volatile("s_waitcnt lgkmcnt(0)" ::: "memory")

constexpr int MTOK = 32768, DM = 1024, DFF = 4096, QKVD = 1280, INEV = 5136, NPROJ = 5120;
constexpr size_t MiB = 1u << 20;
constexpr size_t WS_WGM = 1 * MiB, WS_WIN = 2 * MiB, WS_WOUT = 12 * MiB, WS_WUP0 = 16 * MiB, WS_WUP1 = 24 * MiB, WS_WDN0 = 32 * MiB, WS_WDN1 = 40 * MiB,
                 WS_WQKV = 48 * MiB, WS_WO = 51 * MiB, WS_DT = 53 * MiB, WS_SSP = 55 * MiB, WS_LNP = 57 * MiB, WS_DEC = 61 * MiB, WS_XB = 62 * MiB, WS_ST = 126 * MiB,
                 WS_MIX = 190 * MiB, WS_GV = 318 * MiB, WS_XBC = 382 * MiB, WS_HID = 190 * MiB, WS_QKV = 190 * MiB, WS_ATT = 270 * MiB, WS_END = 510 * MiB;
constexpr int LDS_BYTES = 147456;
constexpr int HIDP = DFF + 64;
constexpr int NPHASE = 14;

typedef __bf16 bf16x2_t __attribute__((ext_vector_type(2)));
__device__ __forceinline__ unsigned pk2(float lo, float hi) { const f32x2 v = {lo, hi}; const bf16x2_t b = __builtin_convertvector(v, bf16x2_t); return __builtin_bit_cast(unsigned, b); }
__device__ __forceinline__ float bflo(unsigned u) { return __uint_as_float(u << 16); }
__device__ __forceinline__ float bfhi(unsigned u) { return __uint_as_float(u & 0xffff0000u); }
__device__ __forceinline__ float ex(float x) { return __builtin_amdgcn_exp2f(x * 1.4426950408889634f); }
__device__ __forceinline__ float rcp(float x) { return __builtin_amdgcn_rcpf(x); }
__device__ __forceinline__ float gelu_t(float x) { const float u = 1.5957691216057308f * (x + 0.044715f * x * x * x); return x * rcp(1.f + ex(-u)); }
__device__ __forceinline__ float silu(float x) { return x * rcp(1.f + ex(-x)); }
__device__ __forceinline__ f32x4 mma(f32x4 acc, bf16x8 a, bf16x8 b) { return __builtin_amdgcn_mfma_f32_16x16x32_bf16(b, a, acc, 0, 0, 0); }
__device__ __forceinline__ int slot32(int n) { return (n & ~31) | (((n >> 2) & 1) << 4) | (((n >> 3) & 3) << 2) | (n & 3); }
__device__ __forceinline__ int unslot32(int s) { return (s & ~31) | (((s >> 2) & 3) << 3) | (((s >> 4) & 1) << 2) | (s & 3); }
__device__ __forceinline__ bf16x8 lds128(LAS unsigned char* lds, int byteoff) { return *(const LAS bf16x8*)(lds + byteoff); }
__device__ __forceinline__ void st16(LAS unsigned char* lds, int byteoff, unsigned v) { *(LAS unsigned short*)(lds + byteoff) = (unsigned short)v; }

struct Args { const float* in[23]; float* out; unsigned char* ws; int ph_lo, ph_hi; };

__device__ __forceinline__ float row_rstd(const float* ssp, size_t row, int fq) {
    const f32x4 p = *(const f32x4*)(ssp + row * 16 + fq * 4);
    float s = (p.x + p.y) + (p.z + p.w);
    s += __shfl_xor(s, 16); s += __shfl_xor(s, 32);
    return rsqrtf(s * (1.f / 1024.f) + 1e-5f);
}
struct EpiInProj {
    static constexpr bool PERM = true, AFTER_DRAIN = false;
    const float* ssp; bf16* mix; bf16* gv; bf16* xbc; float* lnp;
    __device__ __forceinline__ void operator()(const f32x4 (&acc)[2][2][4][2], const pg8::Unit& u, int wr, int wc, int fr, int fq) const {
        const size_t row0 = (size_t)u.pm * 256 + wr * 64 + fr; const int cl = wc * 32 + 8 * fq; const int pn = u.pn;
        bf16* dst; int ld; bool act = false, stats = false;
        if (pn < 4) { dst = mix + pn * 256; ld = 2048; act = true; }
        else if (pn < 8) { dst = gv + (pn - 4) * 256; ld = 1024; act = true; stats = true; }
        else if (pn < 12) { dst = mix + 1024 + (pn - 8) * 256; ld = 2048; }
        else { dst = xbc + (pn - 12) * 256; ld = 2048; }
#pragma unroll
        for (int ai = 0; ai < 2; ++ai)
#pragma unroll
            for (int m = 0; m < 4; ++m) {
                const size_t row = row0 + ai * 128 + m * 16; const float rs = row_rstd(ssp, row, fq);
                float s1 = 0.f, s2 = 0.f;
#pragma unroll
                for (int bj = 0; bj < 2; ++bj) {
                    f32x4 v0 = acc[ai][bj][m][0] * rs, v1 = acc[ai][bj][m][1] * rs;
                    if (act) {
#pragma unroll
                        for (int j = 0; j < 4; ++j) { v0[j] = gelu_t(v0[j]); v1[j] = gelu_t(v1[j]); }
                    }
                    if (stats) {
#pragma unroll
                        for (int j = 0; j < 4; ++j) { s1 += v0[j] + v1[j]; s2 += v0[j] * v0[j] + v1[j] * v1[j]; }
                    }
                    u32x4 w; w.x = pk2(v0[0], v0[1]); w.y = pk2(v0[2], v0[3]); w.z = pk2(v1[0], v1[1]); w.w = pk2(v1[2], v1[3]);
                    *(u32x4*)(dst + row * ld + bj * 128 + cl) = w;
                }
                if (stats) {
                    s1 += __shfl_xor(s1, 16); s1 += __shfl_xor(s1, 32); s2 += __shfl_xor(s2, 16); s2 += __shfl_xor(s2, 32);
                    if (fq == 0) { f32x2 o; o.x = s1; o.y = s2; *(f32x2*)(lnp + (row * 16 + (pn - 4) * 4 + wc) * 2) = o; }
                }
            }
    }
};
struct EpiResid {
    static constexpr bool PERM = true, AFTER_DRAIN = false;
    bf16* xb; float* ssp; const float* bias;
    __device__ __forceinline__ void operator()(const f32x4 (&acc)[2][2][4][2], const pg8::Unit& u, int wr, int wc, int fr, int fq) const {
        const size_t row0 = (size_t)u.pm * 256 + wr * 64 + fr; const int col0 = u.pn * 256 + wc * 32 + 8 * fq;
        f32x4 bv[2][2];
#pragma unroll
        for (int bj = 0; bj < 2; ++bj)
#pragma unroll
            for (int n = 0; n < 2; ++n) bv[bj][n] = bias ? *(const f32x4*)(bias + col0 + bj * 128 + 4 * n) : (f32x4){0.f, 0.f, 0.f, 0.f};
#pragma unroll
        for (int ai = 0; ai < 2; ++ai)
#pragma unroll
            for (int m = 0; m < 4; ++m) {
                const size_t row = row0 + ai * 128 + m * 16; float ss = 0.f;
#pragma unroll
                for (int bj = 0; bj < 2; ++bj) {
                    const size_t off = row * 1024 + col0 + bj * 128;
                    const u32x4 rv = *(const u32x4*)(xb + off);
                    f32x4 v0 = acc[ai][bj][m][0] + bv[bj][0], v1 = acc[ai][bj][m][1] + bv[bj][1];
                    v0[0] += bflo(rv.x); v0[1] += bfhi(rv.x); v0[2] += bflo(rv.y); v0[3] += bfhi(rv.y); v1[0] += bflo(rv.z); v1[1] += bfhi(rv.z); v1[2] += bflo(rv.w); v1[3] += bfhi(rv.w);
#pragma unroll
                    for (int j = 0; j < 4; ++j) ss += v0[j] * v0[j] + v1[j] * v1[j];
                    u32x4 w; w.x = pk2(v0[0], v0[1]); w.y = pk2(v0[2], v0[3]); w.z = pk2(v1[0], v1[1]); w.w = pk2(v1[2], v1[3]);
                    *(u32x4*)(xb + off) = w;
                }
                ss += __shfl_xor(ss, 16); ss += __shfl_xor(ss, 32);
                if (fq == 0) ssp[row * 16 + u.pn * 4 + wc] = ss;
            }
    }
};
struct EpiRelu2 {
    static constexpr bool PERM = true, AFTER_DRAIN = false;
    const float* ssp; bf16* hid;
    __device__ __forceinline__ void operator()(const f32x4 (&acc)[2][2][4][2], const pg8::Unit& u, int wr, int wc, int fr, int fq) const {
        const size_t row0 = (size_t)u.pm * 256 + wr * 64 + fr; const int col0 = u.pn * 256 + wc * 32 + 8 * fq;
#pragma unroll
        for (int ai = 0; ai < 2; ++ai)
#pragma unroll
            for (int m = 0; m < 4; ++m) {
                const size_t row = row0 + ai * 128 + m * 16; const float rs = row_rstd(ssp, row, fq);
#pragma unroll
                for (int bj = 0; bj < 2; ++bj) {
                    f32x4 v0 = acc[ai][bj][m][0] * rs, v1 = acc[ai][bj][m][1] * rs;
#pragma unroll
                    for (int j = 0; j < 4; ++j) { const float a = fmaxf(v0[j], 0.f), b = fmaxf(v1[j], 0.f); v0[j] = a * a; v1[j] = b * b; }
                    u32x4 w; w.x = pk2(v0[0], v0[1]); w.y = pk2(v0[2], v0[3]); w.z = pk2(v1[0], v1[1]); w.w = pk2(v1[2], v1[3]);
                    *(u32x4*)(hid + row * HIDP + col0 + bj * 128) = w;
                }
            }
    }
};
struct EpiQKV {
    static constexpr bool PERM = true, AFTER_DRAIN = false;
    const float* ssp; bf16* o; const float* bias;
    __device__ __forceinline__ void operator()(const f32x4 (&acc)[2][2][4][2], const pg8::Unit& u, int wr, int wc, int fr, int fq) const {
        const size_t row0 = (size_t)u.pm * 256 + wr * 64 + fr; const int col0 = u.pn * 256 + wc * 32 + 8 * fq;
        f32x4 bv[2][2];
#pragma unroll
        for (int bj = 0; bj < 2; ++bj)
#pragma unroll
            for (int n = 0; n < 2; ++n) bv[bj][n] = *(const f32x4*)(bias + col0 + bj * 128 + 4 * n);
#pragma unroll
        for (int ai = 0; ai < 2; ++ai)
#pragma unroll
            for (int m = 0; m < 4; ++m) {
                const size_t row = row0 + ai * 128 + m * 16; const float rs = row_rstd(ssp, row, fq);
#pragma unroll
                for (int bj = 0; bj < 2; ++bj) {
                    const f32x4 v0 = acc[ai][bj][m][0] * rs + bv[bj][0], v1 = acc[ai][bj][m][1] * rs + bv[bj][1];
                    u32x4 w; w.x = pk2(v0[0], v0[1]); w.y = pk2(v0[2], v0[3]); w.z = pk2(v1[0], v1[1]); w.w = pk2(v1[2], v1[3]);
                    *(u32x4*)(o + row * QKVD + col0 + bj * 128) = w;
                }
            }
    }
};

__device__ __forceinline__ void p0_transpose_item(const float* __restrict__ W, int ldw, int K, int nblk, bf16* WT, const float* __restrict__ gain, LAS float* scr, int item, int lane) {
    const int kb = item / nblk, nb = item % nblk, k0 = 64 * kb, n0 = 32 * nb;
#pragma unroll
    for (int i = 0; i < 8; ++i) {
        const int kk = 8 * i + (lane >> 3), c4 = (lane & 7) * 4; const float gs = gain ? gain[k0 + kk] : 1.f;
        const f32x4 v = __builtin_nontemporal_load((const f32x4*)(W + (size_t)(k0 + kk) * ldw + n0 + c4));
        scr[kk * 33 + c4] = v.x * gs; scr[kk * 33 + c4 + 1] = v.y * gs; scr[kk * 33 + c4 + 2] = v.z * gs; scr[kk * 33 + c4 + 3] = v.w * gs;
    }
    LDS_WAIT(); asm volatile("" ::: "memory");
    const int c = lane & 7;
#pragma unroll
    for (int j = 0; j < 4; ++j) { const int n = (lane >> 3) + 8 * j; const LAS float* s = scr + (8 * c) * 33 + n;
        u32x4 o; o.x = pk2(s[0 * 33], s[1 * 33]); o.y = pk2(s[2 * 33], s[3 * 33]); o.z = pk2(s[4 * 33], s[5 * 33]); o.w = pk2(s[6 * 33], s[7 * 33]);
        *(u32x4*)(WT + (size_t)(n0 + n) * K + k0 + 8 * c) = o; }
    LDS_WAIT(); asm volatile("" ::: "memory");
}

__device__ __forceinline__ void phase0(const Args& a, LAS unsigned char* lds, int tid, int lane, int wave, int G) {
    const float* x = a.in[0]; const float* g_mix = a.in[1]; const float* g_mlp = a.in[2]; const float* w_in = a.in[4]; const float* w_out = a.in[5];
    const float* gm_w = a.in[8]; const float* dt_bias = a.in[12]; const float* w_qkv = a.in[16]; const float* w_o = a.in[18]; const float* w_up = a.in[21]; const float* w_dn = a.in[22];
    unsigned char* ws = a.ws;
    bf16* XB = (bf16*)(ws + WS_XB); float* DT = (float*)(ws + WS_DT); float* SSP = (float*)(ws + WS_SSP);
    for (int idx = tid; idx < 16384; idx += 512) { const int k = idx >> 4, j = idx & 15; const float v = w_in[(size_t)k * INEV + NPROJ + j] * g_mix[k]; st16(lds, (j * 1032 + k) * 2, pk2(v, v)); }
    __syncthreads();
    const int gw = blockIdx.x * 8 + wave, NGW = G * 8;
    for (int item = gw; item < MTOK / 16; item += NGW) {
        const int r = lane & 15, q = lane >> 4; const size_t row = (size_t)item * 16 + r;
        const float* xp = x + row * DM + q * 8; bf16* xo = XB + row * DM + q * 8;
        f32x4 acc = {0.f, 0.f, 0.f, 0.f}; float ss = 0.f;
#pragma unroll 8
        for (int kk = 0; kk < 32; ++kk) {
            const f32x4 v0 = __builtin_nontemporal_load((const f32x4*)(xp + kk * 32)), v1 = __builtin_nontemporal_load((const f32x4*)(xp + kk * 32 + 4));
            ss += (v0.x * v0.x + v0.y * v0.y) + (v0.z * v0.z + v0.w * v0.w) + (v1.x * v1.x + v1.y * v1.y) + (v1.z * v1.z + v1.w * v1.w);
            u32x4 w; w.x = pk2(v0.x, v0.y); w.y = pk2(v0.z, v0.w); w.z = pk2(v1.x, v1.y); w.w = pk2(v1.z, v1.w);
            *(u32x4*)(xo + kk * 32) = w;
            const bf16x8 bfr = lds128(lds, (r * 1032 + kk * 32 + q * 8) * 2);
            acc = mma(acc, __builtin_bit_cast(bf16x8, w), bfr);
        }
        ss += __shfl_xor(ss, 16); ss += __shfl_xor(ss, 32);
        const float rstd = rsqrtf(ss * (1.f / 1024.f) + 1e-5f);
        const f32x4 bias = *(const f32x4*)(dt_bias + q * 4);
        f32x4 o;
#pragma unroll
        for (int j = 0; j < 4; ++j) { const float v = acc[j] * rstd + bias[j]; o[j] = v > 20.f ? v : log1pf(expf(v)); }
        *(f32x4*)(DT + row * 16 + q * 4) = o;
        f32x4 sp = {q == 0 ? ss : 0.f, 0.f, 0.f, 0.f};
        *(f32x4*)(SSP + row * 16 + q * 4) = sp;
    }
    __syncthreads();
    LAS float* scr = (LAS float*)(lds + wave * 16384);
    constexpr int I_IN = 16 * 160, I_OUT = 32 * 32, I_UP = 16 * 128, I_DN = 64 * 32, I_QKV = 16 * 40, I_O = 16 * 32;
    constexpr int NITEMS = I_IN + I_OUT + 2 * I_UP + 2 * I_DN + I_QKV + I_O;
    for (int it = gw; it < NITEMS; it += NGW) {
        int r = it;
        if (r < I_IN) { p0_transpose_item(w_in, INEV, 1024, 160, (bf16*)(ws + WS_WIN), g_mix, scr, r, lane); continue; } r -= I_IN;
        if (r < I_OUT) { p0_transpose_item(w_out, 1024, 2048, 32, (bf16*)(ws + WS_WOUT), nullptr, scr, r, lane); continue; } r -= I_OUT;
        if (r < I_UP) { p0_transpose_item(w_up, 4096, 1024, 128, (bf16*)(ws + WS_WUP0), g_mlp, scr, r, lane); continue; } r -= I_UP;
        if (r < I_UP) { p0_transpose_item(w_up + (size_t)1024 * 4096, 4096, 1024, 128, (bf16*)(ws + WS_WUP1), g_mlp + 1024, scr, r, lane); continue; } r -= I_UP;
        if (r < I_DN) { p0_transpose_item(w_dn, 1024, 4096, 32, (bf16*)(ws + WS_WDN0), nullptr, scr, r, lane); continue; } r -= I_DN;
        if (r < I_DN) { p0_transpose_item(w_dn + (size_t)4096 * 1024, 1024, 4096, 32, (bf16*)(ws + WS_WDN1), nullptr, scr, r, lane); continue; } r -= I_DN;
        if (r < I_QKV) { p0_transpose_item(w_qkv, 1280, 1024, 40, (bf16*)(ws + WS_WQKV), g_mix + 1024, scr, r, lane); continue; } r -= I_QKV;
        p0_transpose_item(w_o, 1024, 1024, 32, (bf16*)(ws + WS_WO), nullptr, scr, r, lane);
    }
    bf16* WGM = (bf16*)(ws + WS_WGM);
    for (int idx = blockIdx.x * 512 + tid; idx < 8 * 128 * 128; idx += G * 512) { const int t = (idx >> 7) & 127, s = idx & 127; const float v = (s <= t) ? gm_w[idx] : 0.f; WGM[idx] = (bf16)(pk2(v, v) & 0xffffu); }
}

__device__ __forceinline__ void conv8(const bf16* __restrict__ XBC, size_t grow0, int l, bool first, int col, const float* __restrict__ cw, const float* __restrict__ cb, float (&o)[8]) {
    const f32x4 b0 = *(const f32x4*)(cb + col), b1 = *(const f32x4*)(cb + col + 4);
    o[0] = b0.x; o[1] = b0.y; o[2] = b0.z; o[3] = b0.w; o[4] = b1.x; o[5] = b1.y; o[6] = b1.z; o[7] = b1.w;
#pragma unroll
    for (int tap = 0; tap < 4; ++tap) {
        const int t = l - 3 + tap;
        u32x4 v = {0u, 0u, 0u, 0u};
        if (!first || t >= 0) v = *(const u32x4*)(XBC + (size_t)((long)grow0 + t) * 2048 + col);
        const f32x4 w0 = *(const f32x4*)(cw + tap * 2048 + col), w1 = *(const f32x4*)(cw + tap * 2048 + col + 4);
        o[0] += w0.x * bflo(v.x); o[1] += w0.y * bfhi(v.x); o[2] += w0.z * bflo(v.y); o[3] += w0.w * bfhi(v.y);
        o[4] += w1.x * bflo(v.z); o[5] += w1.y * bfhi(v.z); o[6] += w1.z * bflo(v.w); o[7] += w1.w * bfhi(v.w);
    }
#pragma unroll
    for (int e = 0; e < 8; ++e) o[e] = silu(o[e]);
}
__device__ __forceinline__ void conv8x8(const bf16* __restrict__ XBC, size_t grow0, int l0, bool first, int col, const float* __restrict__ cw, const float* __restrict__ cb, float (&o)[8][8]) {
    float w[4][8];
#pragma unroll
    for (int tap = 0; tap < 4; ++tap) { const f32x4 w0 = *(const f32x4*)(cw + tap * 2048 + col), w1 = *(const f32x4*)(cw + tap * 2048 + col + 4);
        w[tap][0] = w0.x; w[tap][1] = w0.y; w[tap][2] = w0.z; w[tap][3] = w0.w; w[tap][4] = w1.x; w[tap][5] = w1.y; w[tap][6] = w1.z; w[tap][7] = w1.w; }
    { const f32x4 b0 = *(const f32x4*)(cb + col), b1 = *(const f32x4*)(cb + col + 4);
#pragma unroll
      for (int j = 0; j < 8; ++j) { o[j][0] = b0.x; o[j][1] = b0.y; o[j][2] = b0.z; o[j][3] = b0.w; o[j][4] = b1.x; o[j][5] = b1.y; o[j][6] = b1.z; o[j][7] = b1.w; } }
#pragma unroll
    for (int rr = 0; rr < 11; ++rr) {
        const int t = l0 - 3 + rr;
        u32x4 v = {0u, 0u, 0u, 0u};
        if (!first || t >= 0) v = *(const u32x4*)(XBC + (size_t)((long)grow0 + t) * 2048 + col);
        float x[8];
        x[0] = bflo(v.x); x[1] = bfhi(v.x); x[2] = bflo(v.y); x[3] = bfhi(v.y); x[4] = bflo(v.z); x[5] = bfhi(v.z); x[6] = bflo(v.w); x[7] = bfhi(v.w);
#pragma unroll
        for (int tap = 0; tap < 4; ++tap) { const int j = rr - tap; if (j >= 0 && j < 8) {
#pragma unroll
            for (int e = 0; e < 8; ++e) o[j][e] += w[tap][e] * x[e]; } }
    }
#pragma unroll
    for (int j = 0; j < 8; ++j)
#pragma unroll
        for (int e = 0; e < 8; ++e) o[j][e] = silu(o[j][e]);
}
__device__ __forceinline__ float ssd_scan(const float* __restrict__ DT, const float* __restrict__ a_log, size_t grow0, int h, int r, int lane, LAS float* acum, LAS float* dts, float& a0o, float& a1o, float& d0o, float& d1o) {
    const float A = -expf(a_log[h]);
    const float d0 = DT[(grow0 + 2 * lane) * 16 + h], d1 = DT[(grow0 + 2 * lane + 1) * 16 + h];
    const float v0 = d0 * A, v1 = d1 * A, s = v0 + v1;
    float inc = s;
#pragma unroll
    for (int o = 1; o < 64; o <<= 1) { const float t = __shfl_up(inc, o); if (lane >= o) inc += t; }
    const float exc = inc - s, a0 = exc + v0, a1 = exc + s;
    acum[r * 128 + 2 * lane] = a0; acum[r * 128 + 2 * lane + 1] = a1; dts[r * 128 + 2 * lane] = d0; dts[r * 128 + 2 * lane + 1] = d1;
    a0o = a0; a1o = a1; d0o = d0; d1o = d1;
    return __shfl(a1, 63);
}

__device__ __forceinline__ void ssd_a_tile(const Args& a, LAS unsigned char* lds, int tile, int tid, int lane, int wave) {
    { int tz; asm volatile("v_mov_b32 %0, 0" : "=v"(tz)); tid += tz; lane += tz; }
    constexpr int XST = 0, BT = 69632, ACUM = 104448, DTS = ACUM + 2048, TOE = DTS + 2048;
    const int g = tile & 3, bc = tile >> 2, c = bc & 31; const size_t grow0 = (size_t)bc * 128;
    unsigned char* ws = a.ws; const bf16* XBC = (const bf16*)(ws + WS_XBC); const float* DT = (const float*)(ws + WS_DT); float* DEC = (float*)(ws + WS_DEC); bf16* ST = (bf16*)(ws + WS_ST);
    const float* cw = a.in[10]; const float* cb = a.in[11]; const float* a_log = a.in[13];
    if (wave < 4) {
        float a0, a1, d0, d1; const float tot = ssd_scan(DT, a_log, grow0, g * 4 + wave, wave, lane, (LAS float*)(lds + ACUM), (LAS float*)(lds + DTS), a0, a1, d0, d1);
        LAS float* toe = (LAS float*)(lds + TOE);
        toe[wave * 128 + 2 * lane] = ex(tot - a0) * d0; toe[wave * 128 + 2 * lane + 1] = ex(tot - a1) * d1;
        if (lane == 0) DEC[((bc >> 5) * 16 + g * 4 + wave) * 32 + c] = ex(tot);
    }
    __syncthreads();
    {
        const bool first = (c == 0);
        float o[8][8];
        {
            const int chg = tid & 31, l0 = (tid >> 5) * 8;
            conv8x8(XBC, grow0, l0, first, g * 256 + chg * 8, cw, cb, o);
            const LAS float* toe = (const LAS float*)(lds + TOE) + (chg >> 3) * 128 + l0;
            const f32x4 t0 = *(const LAS f32x4*)toe, t1 = *(const LAS f32x4*)(toe + 4);
#pragma unroll
            for (int e = 0; e < 8; ++e) {
                u32x4 w; w.x = pk2(o[0][e] * t0.x, o[1][e] * t0.y); w.y = pk2(o[2][e] * t0.z, o[3][e] * t0.w); w.z = pk2(o[4][e] * t1.x, o[5][e] * t1.y); w.w = pk2(o[6][e] * t1.z, o[7][e] * t1.w);
                *(LAS u32x4*)(lds + XST + ((chg * 8 + e) * 136 + l0) * 2) = w;
            }
        }
        if (tid < 256) {
            const int chg = tid & 15, l0 = (tid >> 4) * 8;
            conv8x8(XBC, grow0, l0, first, 1024 + g * 128 + chg * 8, cw, cb, o);
#pragma unroll
            for (int e = 0; e < 8; ++e) {
                u32x4 w; w.x = pk2(o[0][e], o[1][e]); w.y = pk2(o[2][e], o[3][e]); w.z = pk2(o[4][e], o[5][e]); w.w = pk2(o[6][e], o[7][e]);
                *(LAS u32x4*)(lds + BT + (slot32(chg * 8 + e) * 136 + l0) * 2) = w;
            }
        }
    }
    __syncthreads();
    {
        const int r = wave >> 1, ph = wave & 1, lr = lane & 15, q = lane >> 4;
        f32x4 acc[2][8];
#pragma unroll
        for (int mt = 0; mt < 2; ++mt)
#pragma unroll
            for (int nt = 0; nt < 8; ++nt) acc[mt][nt] = (f32x4){0.f, 0.f, 0.f, 0.f};
#pragma unroll
        for (int ks = 0; ks < 4; ++ks) {
            bf16x8 af[2];
#pragma unroll
            for (int mt = 0; mt < 2; ++mt) af[mt] = lds128(lds, XST + ((r * 64 + ph * 32 + mt * 16 + lr) * 136 + ks * 32 + q * 8) * 2);
#pragma unroll
            for (int nt = 0; nt < 8; ++nt) {
                const bf16x8 bfr = lds128(lds, BT + ((nt * 16 + lr) * 136 + ks * 32 + q * 8) * 2);
#pragma unroll
                for (int mt = 0; mt < 2; ++mt) acc[mt][nt] = mma(acc[mt][nt], af[mt], bfr);
            }
        }
        bf16* stp = ST + ((size_t)bc * 16 + g * 4 + r) * 8192;
#pragma unroll
        for (int mt = 0; mt < 2; ++mt)
#pragma unroll
            for (int G2 = 0; G2 < 4; ++G2) {
                const int p = ph * 32 + mt * 16 + lr, n = G2 * 32 + q * 8;
                u32x4 w; w.x = pk2(acc[mt][2 * G2][0], acc[mt][2 * G2][1]); w.y = pk2(acc[mt][2 * G2][2], acc[mt][2 * G2][3]);
                w.z = pk2(acc[mt][2 * G2 + 1][0], acc[mt][2 * G2 + 1][1]); w.w = pk2(acc[mt][2 * G2 + 1][2], acc[mt][2 * G2 + 1][3]);
                *(u32x4*)(stp + p * 128 + n) = w;
            }
    }
    __syncthreads();
}

__device__ __forceinline__ void gmlp_tile(const Args& a, LAS unsigned char* lds, int tile, int tid, int lane, int wave) {
    constexpr int VNT = 0;
    const int g = tile & 7, bc = tile >> 3; const size_t grow0 = (size_t)bc * 128;
    unsigned char* ws = a.ws; const bf16* GV = (const bf16*)(ws + WS_GV); const float* LNP = (const float*)(ws + WS_LNP); bf16* MIX = (bf16*)(ws + WS_MIX); const bf16* WGM = (const bf16*)(ws + WS_WGM);
    const float* ln_g = a.in[6]; const float* ln_b = a.in[7]; const float* b_s = a.in[9];
    {
        const int srow = tid >> 2, part = tid & 3; const size_t row = grow0 + srow;
        const f32x4 p0 = *(const f32x4*)(LNP + row * 32 + part * 8), p1 = *(const f32x4*)(LNP + row * 32 + part * 8 + 4);
        float s1 = (p0.x + p0.z) + (p1.x + p1.z), s2 = (p0.y + p0.w) + (p1.y + p1.w);
        s1 += __shfl_xor(s1, 1); s1 += __shfl_xor(s1, 2); s2 += __shfl_xor(s2, 1); s2 += __shfl_xor(s2, 2);
        const float mean = s1 * (1.f / 1024.f), var = s2 * (1.f / 1024.f) - mean * mean, rstd = rsqrtf(var + 1e-5f);
        if (part == 0) { f32x2 ms; ms.x = mean; ms.y = rstd; *(LAS f32x2*)(lds + 34816 + srow * 8) = ms; }
    }
    __syncthreads();
    {
        const int chg = tid & 15, s0 = (tid >> 4) * 4, ch = g * 128 + chg * 8;
        const f32x4 g0 = *(const f32x4*)(ln_g + ch), g1 = *(const f32x4*)(ln_g + ch + 4), c0 = *(const f32x4*)(ln_b + ch), c1 = *(const f32x4*)(ln_b + ch + 4);
        float val[4][8];
#pragma unroll
        for (int jj = 0; jj < 4; ++jj) {
            const u32x4 v = *(const u32x4*)(GV + (grow0 + s0 + jj) * 1024 + ch);
            const f32x2 ms = *(const LAS f32x2*)(lds + 34816 + (s0 + jj) * 8);
            const float mean = ms.x, rstd = ms.y;
            val[jj][0] = (bflo(v.x) - mean) * rstd * g0.x + c0.x; val[jj][1] = (bfhi(v.x) - mean) * rstd * g0.y + c0.y; val[jj][2] = (bflo(v.y) - mean) * rstd * g0.z + c0.z; val[jj][3] = (bfhi(v.y) - mean) * rstd * g0.w + c0.w;
            val[jj][4] = (bflo(v.z) - mean) * rstd * g1.x + c1.x; val[jj][5] = (bfhi(v.z) - mean) * rstd * g1.y + c1.y; val[jj][6] = (bflo(v.w) - mean) * rstd * g1.z + c1.z; val[jj][7] = (bfhi(v.w) - mean) * rstd * g1.w + c1.w;
        }
#pragma unroll
        for (int e = 0; e < 8; ++e) { u32x2 w; w.x = pk2(val[0][e], val[1][e]); w.y = pk2(val[2][e], val[3][e]); *(LAS u32x2*)(lds + VNT + (slot32(chg * 8 + e) * 136 + s0) * 2) = w; }
    }
    __syncthreads();
    {
        const int wr = wave >> 1, wc = wave & 1, lr = lane & 15, q = lane >> 4;
        f32x4 acc[2][4];
#pragma unroll
        for (int mt = 0; mt < 2; ++mt)
#pragma unroll
            for (int nt = 0; nt < 4; ++nt) acc[mt][nt] = (f32x4){0.f, 0.f, 0.f, 0.f};
        for (int ks = 0; ks <= wr; ++ks) {
            bf16x8 af[2];
#pragma unroll
            for (int mt = 0; mt < 2; ++mt) af[mt] = *(const bf16x8*)(WGM + g * 16384 + (wr * 32 + mt * 16 + lr) * 128 + ks * 32 + q * 8);
#pragma unroll
            for (int nt = 0; nt < 4; ++nt) {
                const bf16x8 bfr = lds128(lds, VNT + ((wc * 64 + nt * 16 + lr) * 136 + ks * 32 + q * 8) * 2);
#pragma unroll
                for (int mt = 0; mt < 2; ++mt) acc[mt][nt] = mma(acc[mt][nt], af[mt], bfr);
            }
        }
#pragma unroll
        for (int mt = 0; mt < 2; ++mt) {
            const int t = wr * 32 + mt * 16 + lr; const float bias = b_s[g * 128 + t];
#pragma unroll
            for (int G2 = 0; G2 < 2; ++G2) {
                bf16* p = MIX + (grow0 + t) * 2048 + g * 128 + wc * 64 + G2 * 32 + q * 8;
                const u32x4 uu = *(const u32x4*)p;
                u32x4 w; w.x = pk2((acc[mt][2 * G2][0] + bias) * bflo(uu.x), (acc[mt][2 * G2][1] + bias) * bfhi(uu.x)); w.y = pk2((acc[mt][2 * G2][2] + bias) * bflo(uu.y), (acc[mt][2 * G2][3] + bias) * bfhi(uu.y));
                w.z = pk2((acc[mt][2 * G2 + 1][0] + bias) * bflo(uu.z), (acc[mt][2 * G2 + 1][1] + bias) * bfhi(uu.z)); w.w = pk2((acc[mt][2 * G2 + 1][2] + bias) * bflo(uu.w), (acc[mt][2 * G2 + 1][3] + bias) * bfhi(uu.w));
                *(u32x4*)p = w;
            }
        }
    }
    __syncthreads();
}

__device__ __forceinline__ void scan_phase(const Args& a, int tid, int G) {
    bf16* ST = (bf16*)(a.ws + WS_ST); const float* DEC = (const float*)(a.ws + WS_DEC);
    for (int idx = blockIdx.x * 512 + tid; idx < 131072; idx += G * 512) {
        const int pn8 = idx & 1023, h = (idx >> 10) & 15, b = idx >> 14;
        float st[8];
#pragma unroll
        for (int e = 0; e < 8; ++e) st[e] = 0.f;
#pragma unroll 1
        for (int c0 = 0; c0 < 32; c0 += 8) {
            u32x4 v[8]; float dec[8];
#pragma unroll
            for (int cc = 0; cc < 8; ++cc) { const size_t bch = ((size_t)(b * 32 + c0 + cc)) * 16 + h; v[cc] = *(const u32x4*)(ST + bch * 8192 + pn8 * 8); }
            { const f32x4 d0 = *(const f32x4*)(DEC + (b * 16 + h) * 32 + c0), d1 = *(const f32x4*)(DEC + (b * 16 + h) * 32 + c0 + 4);
              dec[0] = d0.x; dec[1] = d0.y; dec[2] = d0.z; dec[3] = d0.w; dec[4] = d1.x; dec[5] = d1.y; dec[6] = d1.z; dec[7] = d1.w; }
#pragma unroll
            for (int cc = 0; cc < 8; ++cc) {
                const size_t bch = ((size_t)(b * 32 + c0 + cc)) * 16 + h;
                u32x4 w; w.x = pk2(st[0], st[1]); w.y = pk2(st[2], st[3]); w.z = pk2(st[4], st[5]); w.w = pk2(st[6], st[7]);
                *(u32x4*)(ST + bch * 8192 + pn8 * 8) = w;
                const float d = dec[cc];
                st[0] = d * st[0] + bflo(v[cc].x); st[1] = d * st[1] + bfhi(v[cc].x); st[2] = d * st[2] + bflo(v[cc].y); st[3] = d * st[3] + bfhi(v[cc].y);
                st[4] = d * st[4] + bflo(v[cc].z); st[5] = d * st[5] + bfhi(v[cc].z); st[6] = d * st[6] + bflo(v[cc].w); st[7] = d * st[7] + bfhi(v[cc].w);
            }
        }
    }
}

__device__ __forceinline__ void ssd_b_tile(const Args& a, LAS unsigned char* lds, int tile, int tid, int lane, int wave) {
    { int tz; asm volatile("v_mov_b32 %0, 0" : "=v"(tz)); tid += tz; lane += tz; }
    constexpr int XST = 0, CM = 69632, BM = 104448, ACUM = 139264, DTS = ACUM + 2048, PSS = DTS + 2048;
    const int g = tile & 3, bc = tile >> 2, c = bc & 31; const size_t grow0 = (size_t)bc * 128;
    unsigned char* ws = a.ws; const bf16* XBC = (const bf16*)(ws + WS_XBC); const float* DT = (const float*)(ws + WS_DT); const bf16* ST = (const bf16*)(ws + WS_ST); bf16* MIX = (bf16*)(ws + WS_MIX);
    const float* cw = a.in[10]; const float* cb = a.in[11]; const float* a_log = a.in[13]; const float* d_skip = a.in[14]; const float* norm_g = a.in[15];
    if (wave < 4) { float a0, a1, d0, d1; (void)ssd_scan(DT, a_log, grow0, g * 4 + wave, wave, lane, (LAS float*)(lds + ACUM), (LAS float*)(lds + DTS), a0, a1, d0, d1); }
    {
        const bool first = (c == 0);
        float o[8][8];
        {
            const int chg = tid & 31, l0 = (tid >> 5) * 8;
            conv8x8(XBC, grow0, l0, first, g * 256 + chg * 8, cw, cb, o);
#pragma unroll
            for (int e = 0; e < 8; ++e) {
                u32x4 w; w.x = pk2(o[0][e], o[1][e]); w.y = pk2(o[2][e], o[3][e]); w.z = pk2(o[4][e], o[5][e]); w.w = pk2(o[6][e], o[7][e]);
                *(LAS u32x4*)(lds + XST + ((chg * 8 + e) * 136 + l0) * 2) = w;
            }
        }
        {
            const int half = tid >> 8, chg = tid & 15, l0 = ((tid >> 4) & 15) * 8;
            conv8x8(XBC, grow0, l0, first, (half ? 1536 : 1024) + g * 128 + chg * 8, cw, cb, o);
            const int dstb = half ? CM : BM;
#pragma unroll
            for (int j = 0; j < 8; ++j) {
                u32x4 w; w.x = pk2(o[j][0], o[j][1]); w.y = pk2(o[j][2], o[j][3]); w.z = pk2(o[j][4], o[j][5]); w.w = pk2(o[j][6], o[j][7]);
                *(LAS u32x4*)(lds + dstb + ((l0 + j) * 136 + chg * 8) * 2) = w;
            }
        }
    }
    __syncthreads();
    const int lr = lane & 15, q = lane >> 4;
    const int r = wave >> 1, lh = wave & 1, h = g * 4 + r;
    bf16x8 pv[4][4];
    {
        const bf16* prev = ST + ((size_t)bc * 16 + h) * 8192;
#pragma unroll
        for (int ks = 0; ks < 4; ++ks)
#pragma unroll
            for (int nt = 0; nt < 4; ++nt) pv[ks][nt] = *(const bf16x8*)(prev + (nt * 16 + lr) * 128 + ks * 32 + q * 8);
    }
    {
        const int wr4 = wave >> 1, wc2 = wave & 1;
        f32x4 cbv[2][4];
#pragma unroll
        for (int mt = 0; mt < 2; ++mt)
#pragma unroll
            for (int nt = 0; nt < 4; ++nt) cbv[mt][nt] = (f32x4){0.f, 0.f, 0.f, 0.f};
#pragma unroll
        for (int ks = 0; ks < 4; ++ks) {
            bf16x8 af[2];
#pragma unroll
            for (int mt = 0; mt < 2; ++mt) af[mt] = lds128(lds, CM + ((wr4 * 32 + mt * 16 + lr) * 136 + ks * 32 + q * 8) * 2);
#pragma unroll
            for (int nt = 0; nt < 4; ++nt) {
                const bf16x8 bfr = lds128(lds, BM + ((wc2 * 64 + nt * 16 + lr) * 136 + ks * 32 + q * 8) * 2);
#pragma unroll
                for (int mt = 0; mt < 2; ++mt) cbv[mt][nt] = mma(cbv[mt][nt], af[mt], bfr);
            }
        }
        __syncthreads();
#pragma unroll
        for (int mt = 0; mt < 2; ++mt)
#pragma unroll
            for (int nt = 0; nt < 4; ++nt) {
                u32x2 w; w.x = pk2(cbv[mt][nt][0], cbv[mt][nt][1]); w.y = pk2(cbv[mt][nt][2], cbv[mt][nt][3]);
                *(LAS u32x2*)(lds + BM + ((wr4 * 32 + mt * 16 + lr) * 136 + wc2 * 64 + nt * 16 + q * 4) * 2) = w;
            }
        __syncthreads();
    }
    const LAS float* acum = (const LAS float*)(lds + ACUM) + r * 128; const LAS float* dts = (const LAS float*)(lds + DTS) + r * 128;
    f32x4 acc[4][4];
#pragma unroll
    for (int mt = 0; mt < 4; ++mt)
#pragma unroll
        for (int nt = 0; nt < 4; ++nt) acc[mt][nt] = (f32x4){0.f, 0.f, 0.f, 0.f};
    {
#pragma unroll
        for (int ks = 0; ks < 4; ++ks) {
            bf16x8 af[4];
#pragma unroll
            for (int mt = 0; mt < 4; ++mt) af[mt] = lds128(lds, CM + ((lh * 64 + mt * 16 + lr) * 136 + ks * 32 + q * 8) * 2);
#pragma unroll
            for (int nt = 0; nt < 4; ++nt)
#pragma unroll
                for (int mt = 0; mt < 4; ++mt) acc[mt][nt] = mma(acc[mt][nt], af[mt], pv[ks][nt]);
        }
    }
    float al[4];
#pragma unroll
    for (int mt = 0; mt < 4; ++mt) { al[mt] = acum[lh * 64 + mt * 16 + lr]; const float sc = ex(al[mt]);
#pragma unroll
        for (int nt = 0; nt < 4; ++nt) acc[mt][nt] = acc[mt][nt] * sc; }
#pragma unroll 1
    for (int ks = 0; ks <= lh * 2 + 1; ++ks) {
        const int s0 = ks * 32 + q * 8;
        const f32x4 as0 = *(const LAS f32x4*)(acum + s0), as1 = *(const LAS f32x4*)(acum + s0 + 4), dd0 = *(const LAS f32x4*)(dts + s0), dd1 = *(const LAS f32x4*)(dts + s0 + 4);
        bf16x8 bx[4];
#pragma unroll
        for (int nt = 0; nt < 4; ++nt) bx[nt] = lds128(lds, XST + ((r * 64 + nt * 16 + lr) * 136 + s0) * 2);
#pragma unroll
        for (int mt = 0; mt < 4; ++mt) {
            if (lh * 64 + mt * 16 + 15 < ks * 32) continue;
            const int l = lh * 64 + mt * 16 + lr;
            const u32x4 raw = *(const LAS u32x4*)(lds + BM + (l * 136 + s0) * 2);
            float w[8];
            w[0] = bflo(raw.x); w[1] = bfhi(raw.x); w[2] = bflo(raw.y); w[3] = bfhi(raw.y); w[4] = bflo(raw.z); w[5] = bfhi(raw.z); w[6] = bflo(raw.w); w[7] = bfhi(raw.w);
#pragma unroll
            for (int e = 0; e < 8; ++e) {
                const float as = e < 4 ? as0[e & 3] : as1[e & 3], dd = e < 4 ? dd0[e & 3] : dd1[e & 3];
                const bool valid = (s0 + e) <= l;
                const float arg = valid ? (al[mt] - as) : 0.f;
                w[e] = valid ? w[e] * ex(arg) * dd : 0.f;
            }
            u32x4 pw; pw.x = pk2(w[0], w[1]); pw.y = pk2(w[2], w[3]); pw.z = pk2(w[4], w[5]); pw.w = pk2(w[6], w[7]);
            const bf16x8 af = __builtin_bit_cast(bf16x8, pw);
#pragma unroll
            for (int nt = 0; nt < 4; ++nt) acc[mt][nt] = mma(acc[mt][nt], af, bx[nt]);
        }
    }
    const float dsk = d_skip[h];
#pragma unroll
    for (int mt = 0; mt < 4; ++mt) {
        const int l = lh * 64 + mt * 16 + lr; float ssq = 0.f;
#pragma unroll
        for (int nt = 0; nt < 4; ++nt) {
            const int ch = r * 64 + nt * 16 + q * 4;
            const u32x2 zz = *(const u32x2*)(MIX + (grow0 + l) * 2048 + 1024 + g * 256 + ch);
            float xs[4], zf[4];
            zf[0] = bflo(zz.x); zf[1] = bfhi(zz.x); zf[2] = bflo(zz.y); zf[3] = bfhi(zz.y);
#pragma unroll
            for (int j = 0; j < 4; ++j) xs[j] = __uint_as_float(((unsigned)*(const LAS unsigned short*)(lds + XST + ((ch + j) * 136 + l) * 2)) << 16);
#pragma unroll
            for (int j = 0; j < 4; ++j) { const float y = (acc[mt][nt][j] + dsk * xs[j]) * silu(zf[j]); acc[mt][nt][j] = y; ssq += y * y; }
        }
        ssq += __shfl_xor(ssq, 16); ssq += __shfl_xor(ssq, 32);
        if (q == 0) ((LAS float*)(lds + PSS))[r * 128 + l] = ssq;
        __builtin_amdgcn_sched_barrier(0);
    }
    __syncthreads();
#pragma unroll
    for (int mt = 0; mt < 4; ++mt) {
        const int l = lh * 64 + mt * 16 + lr; const LAS float* pss = (const LAS float*)(lds + PSS);
        const float tot = (pss[l] + pss[128 + l]) + (pss[256 + l] + pss[384 + l]);
        const float rs = rsqrtf(tot * (1.f / 256.f) + 1e-5f);
#pragma unroll
        for (int nt = 0; nt < 4; ++nt) {
            const int ch = r * 64 + nt * 16 + q * 4;
            const f32x4 ng = *(const f32x4*)(norm_g + g * 256 + ch);
            u32x2 w; w.x = pk2(acc[mt][nt][0] * rs * ng.x, acc[mt][nt][1] * rs * ng.y); w.y = pk2(acc[mt][nt][2] * rs * ng.z, acc[mt][nt][3] * rs * ng.w);
            *(u32x2*)(MIX + (grow0 + l) * 2048 + 1024 + g * 256 + ch) = w;
        }
        __builtin_amdgcn_sched_barrier(0);
    }
    __syncthreads();
}

__device__ __forceinline__ void attn_tile(const Args& a, LAS unsigned char* lds, int tile, int tid, int lane, int wave) {
    constexpr int KB = 0, VT = 36864;
    const int kvh = tile & 1, bn = tile >> 1, nb = bn & 31;
    const bf16* QKV = (const bf16*)(a.ws + WS_QKV); bf16* ATT = (bf16*)(a.ws + WS_ATT); const float* sinks = a.in[20];
    if (tid < 256) {
        const int d0 = (tid & 7) * 8, s0 = (tid >> 3) * 8;
        u32x4 v[8];
#pragma unroll
        for (int j = 0; j < 8; ++j) { const int sk = s0 + j; v[j] = (u32x4){0u, 0u, 0u, 0u};
            if (nb > 0 || sk >= 128) v[j] = *(const u32x4*)(QKV + ((long)bn * 128 - 128 + sk) * QKVD + 1152 + kvh * 64 + d0); }
#pragma unroll
        for (int e = 0; e < 8; ++e) {
            unsigned hh[8];
#pragma unroll
            for (int j = 0; j < 8; ++j) { const unsigned wd = v[j][e >> 1]; hh[j] = (e & 1) ? (wd >> 16) : (wd & 0xffffu); }
            u32x4 w; w.x = hh[0] | (hh[1] << 16); w.y = hh[2] | (hh[3] << 16); w.z = hh[4] | (hh[5] << 16); w.w = hh[6] | (hh[7] << 16);
            *(LAS u32x4*)(lds + VT + (slot32(d0 + e) * 264 + s0) * 2) = w;
        }
    } else {
        const int t2 = tid - 256;
#pragma unroll
        for (int i = 0; i < 8; ++i) {
            const int p = t2 + 256 * i, sk = p >> 3, pc = p & 7;
            u32x4 kv = {0u, 0u, 0u, 0u};
            if (nb > 0 || sk >= 128) kv = *(const u32x4*)(QKV + ((long)bn * 128 - 128 + sk) * QKVD + 1024 + kvh * 64 + pc * 8);
            *(LAS u32x4*)(lds + KB + (sk * 72 + pc * 8) * 2) = kv;
        }
    }
    __syncthreads();
    const int h = kvh * 8 + wave, lr = lane & 15, q4 = lane >> 4; const float sink = sinks[h];
    bf16x8 aqn[2];
#pragma unroll
    for (int ks = 0; ks < 2; ++ks) aqn[ks] = *(const bf16x8*)(QKV + ((size_t)bn * 128 + lr) * QKVD + h * 64 + ks * 32 + q4 * 8);
#pragma unroll 1
    for (int qc = 0; qc < 8; ++qc) {
        const int qi = qc * 16 + lr; const size_t qrow = (size_t)bn * 128 + qi;
        bf16x8 aq[2];
#pragma unroll
        for (int ks = 0; ks < 2; ++ks) aq[ks] = aqn[ks];
        { const size_t qnext = qrow + (qc < 7 ? 16 : 0);
#pragma unroll
          for (int ks = 0; ks < 2; ++ks) aqn[ks] = *(const bf16x8*)(QKV + qnext * QKVD + h * 64 + ks * 32 + q4 * 8); }
        f32x4 sc[10];
#pragma unroll
        for (int t = 0; t < 9; ++t) {
            sc[t] = (f32x4){0.f, 0.f, 0.f, 0.f};
#pragma unroll
            for (int ks = 0; ks < 2; ++ks) sc[t] = mma(sc[t], aq[ks], lds128(lds, KB + (((qc + t) * 16 + lr) * 72 + ks * 32 + q4 * 8) * 2));
        }
        sc[9] = (f32x4){0.f, 0.f, 0.f, 0.f};
        float m = sink;
#pragma unroll
        for (int t = 0; t < 9; ++t)
#pragma unroll
            for (int j = 0; j < 4; ++j) {
                const int si = (qc + t) * 16 + q4 * 4 + j;
                const bool valid = (si >= qi + 1) && (si <= qi + 128) && (nb > 0 || si >= 128);
                const float v = valid ? sc[t][j] * 0.125f : -INFINITY;
                sc[t][j] = v; m = fmaxf(m, v);
            }
        m = fmaxf(m, __shfl_xor(m, 16)); m = fmaxf(m, __shfl_xor(m, 32));
        float sum = 0.f;
#pragma unroll
        for (int t = 0; t < 9; ++t)
#pragma unroll
            for (int j = 0; j < 4; ++j) { const float p = ex(sc[t][j] - m); sc[t][j] = p; sum += p; }
        sum += __shfl_xor(sum, 16); sum += __shfl_xor(sum, 32);
        const float inv = 1.f / (sum + ex(sink - m));
        f32x4 o[4];
#pragma unroll
        for (int dt = 0; dt < 4; ++dt) o[dt] = (f32x4){0.f, 0.f, 0.f, 0.f};
#pragma unroll
        for (int kk = 0; kk < 5; ++kk) {
            const int t0 = 2 * kk, t1 = 2 * kk + 1;
            u32x4 pw; pw.x = pk2(sc[t0][0], sc[t0][1]); pw.y = pk2(sc[t0][2], sc[t0][3]); pw.z = pk2(sc[t1][0], sc[t1][1]); pw.w = pk2(sc[t1][2], sc[t1][3]);
            const bf16x8 af = __builtin_bit_cast(bf16x8, pw);
            const int T0 = qc + t0, T1 = (qc + t1) > 15 ? 15 : (qc + t1);
#pragma unroll
            for (int dt = 0; dt < 4; ++dt) {
                const u32x2 b0 = *(const LAS u32x2*)(lds + VT + ((dt * 16 + lr) * 264 + T0 * 16 + q4 * 4) * 2), b1 = *(const LAS u32x2*)(lds + VT + ((dt * 16 + lr) * 264 + T1 * 16 + q4 * 4) * 2);
                u32x4 bw; bw.x = b0.x; bw.y = b0.y; bw.z = b1.x; bw.w = b1.y;
                o[dt] = mma(o[dt], af, __builtin_bit_cast(bf16x8, bw));
            }
        }
#pragma unroll
        for (int G2 = 0; G2 < 2; ++G2) {
            u32x4 w; w.x = pk2(o[2 * G2][0] * inv, o[2 * G2][1] * inv); w.y = pk2(o[2 * G2][2] * inv, o[2 * G2][3] * inv);
            w.z = pk2(o[2 * G2 + 1][0] * inv, o[2 * G2 + 1][1] * inv); w.w = pk2(o[2 * G2 + 1][2] * inv, o[2 * G2 + 1][3] * inv);
            *(u32x4*)(ATT + qrow * 1024 + h * 64 + G2 * 32 + q4 * 8) = w;
        }
    }
    __syncthreads();
}

__device__ __forceinline__ float wave_sum(float v) {
#pragma unroll
    for (int o = 1; o < 64; o <<= 1) v += __shfl_xor(v, o);
    return v;
}

#define XB_TMO      128
#define XB_XCNT(j)  (256  + 64 * (j))
#define XB_XSUB(j)  (1280 + 64 * (j))
#define XB_XGEN(j)  (2304 + 64 * (j))
#define XB_TOP      3328
#define XB_TOPGEN   3392
#define XCD_BAR_WORDS 3456
#define XB_SPIN_CAP (1u << 18)

__device__ __forceinline__ unsigned xb_ld(unsigned* p)              { return __hip_atomic_load(p, __ATOMIC_RELAXED, __HIP_MEMORY_SCOPE_AGENT); }
__device__ __forceinline__ unsigned xb_add(unsigned* p, unsigned v) { return __hip_atomic_fetch_add(p, v, __ATOMIC_RELAXED, __HIP_MEMORY_SCOPE_AGENT); }
__device__ __forceinline__ unsigned xb_xcc_id() { return (unsigned)__builtin_amdgcn_s_getreg((3 << 11) | 20) & 0xFu; }
#define XB_SPIN(cond, bar) do { unsigned _sp = 0; while (cond) { __builtin_amdgcn_s_sleep(1); \
    if ((++_sp & 255u) == 0u) { if (xb_ld(&(bar)[XB_TMO])) break; if (_sp > XB_SPIN_CAP) { atomicAdd(&(bar)[XB_TMO], 1u); break; } } } } while (0)

struct XcdBarrier {
    unsigned* bar; unsigned x;
    volatile LAS unsigned* st;
};

__device__ __forceinline__ XcdBarrier xcd_barrier_post(unsigned* bar, volatile LAS unsigned* st) {
    XcdBarrier b; b.bar = bar; b.x = xb_xcc_id(); b.st = st;
    if (threadIdx.x == 0) (void)xb_add(&bar[XB_XCNT(b.x)], 1u);
    return b;
}
__device__ __forceinline__ void xcd_barrier_complete(unsigned* bar, unsigned x, unsigned& nloc, unsigned& nx) {
    const unsigned G = gridDim.x * gridDim.y * gridDim.z;
    unsigned sum, cnt, mine, sp = 0u;
    for (;;) {
        sum = 0u; cnt = 0u; mine = 0u;
#pragma unroll
        for (unsigned j = 0; j < 16; ++j) { const unsigned c = xb_ld(&bar[XB_XCNT(j)]); sum += c; cnt += (c > 0u) ? 1u : 0u; mine = (j == x) ? c : mine; }
        if (sum == G) break;
        __builtin_amdgcn_s_sleep(1);
        if ((++sp & 255u) == 0u) { if (xb_ld(&bar[XB_TMO])) break; if (sp > XB_SPIN_CAP) { atomicAdd(&bar[XB_TMO], 1u); break; } }
    }
    nloc = mine > 0u ? mine : 1u; nx = cnt > 0u ? cnt : 1u;
}

__device__ __forceinline__ void xcd_barrier(const XcdBarrier& b) {
    asm volatile("s_waitcnt vmcnt(0)" ::: "memory");
    __syncthreads();
    if (threadIdx.x == 0) {
        unsigned* bar = b.bar;
        __builtin_amdgcn_s_waitcnt(0);
        unsigned nloc = b.st[0], nx = b.st[1];
        if (nloc == 0u) { xcd_barrier_complete(bar, b.x, nloc, nx); b.st[0] = nloc; b.st[1] = nx; }
        const unsigned old = xb_add(&bar[XB_XSUB(b.x)], 1u);
        const unsigned gen = old / nloc;
        if (old + 1u == (gen + 1u) * nloc) {
            __builtin_amdgcn_fence(__ATOMIC_RELEASE, "agent");
            asm volatile("s_waitcnt vmcnt(0)" ::: "memory");
            const unsigned og = xb_add(&bar[XB_TOP], 1u);
            const unsigned tg = og / nx;
            if (og + 1u == (tg + 1u) * nx) xb_add(&bar[XB_TOPGEN], 1u);
            else XB_SPIN(xb_ld(&bar[XB_TOPGEN]) == tg, bar);
            __builtin_amdgcn_fence(__ATOMIC_ACQUIRE, "agent");
            xb_add(&bar[XB_XGEN(b.x)], 1u);
            asm volatile("s_waitcnt vmcnt(0)" ::: "memory");
        } else {
            XB_SPIN(xb_ld(&bar[XB_XGEN(b.x)]) == gen, bar);
            __builtin_amdgcn_fence(__ATOMIC_ACQUIRE, "agent");
            asm volatile("s_waitcnt vmcnt(0)" ::: "memory");
        }
    }
    __syncthreads();
}

__global__ void __launch_bounds__(512, 2) hybrid_fwd(Args args) {
    extern __shared__ __attribute__((aligned(16))) unsigned char lds_raw[];
    LAS unsigned char* lds = (LAS unsigned char*)lds_raw;
    const int tid = threadIdx.x, lane = tid & 63, wave = __builtin_amdgcn_readfirstlane(tid >> 6), G = gridDim.x;
    unsigned char* ws = args.ws;
    const int lo = args.ph_lo, hi = args.ph_hi;
    cg::grid_group grid = cg::this_grid();
    if (lo > hi) grid.sync();
    volatile LAS unsigned* bst = (volatile LAS unsigned*)(lds + LDS_BYTES - 16);
    if (tid < 4) bst[tid] = 0u;
    __syncthreads();
    XcdBarrier bar = xcd_barrier_post((unsigned*)ws, bst);
#ifndef PH_MASK
#define PH_MASK 0x3fff
#endif
#define IN(k) (((PH_MASK >> (k)) & 1) && lo <= (k) && (k) < hi)
#define SEAM(k) do { if (IN(k) && IN((k) + 1)) { xcd_barrier(bar); } } while (0)
    bf16* XB = (bf16*)(ws + WS_XB); float* SSP = (float*)(ws + WS_SSP); float* H = args.out;

    if (IN(0)) { phase0(args, lds, tid, lane, wave, G); } SEAM(0);
    if (IN(1)) {
        pg8::Gemm g{XB, (const bf16*)(ws + WS_WIN), MTOK, NPROJ, DM}; pg8::StaticOrder S; S.init(MTOK, NPROJ, G, (int)blockIdx.x);
        EpiInProj E{SSP, (bf16*)(ws + WS_MIX), (bf16*)(ws + WS_GV), (bf16*)(ws + WS_XBC), (float*)(ws + WS_LNP)};
        pg8::gemm_phase<EpiInProj, pg8::StaticOrder, true, true>(lds, g, S, E);
    } SEAM(1);
    if (IN(2)) {
        for (int t = blockIdx.x; t < 1024 + 2048; t += G) { if (t < 1024) ssd_a_tile(args, lds, t, tid, lane, wave); else gmlp_tile(args, lds, t - 1024, tid, lane, wave); }
    } SEAM(2);
    if (IN(3)) { scan_phase(args, tid, G); } SEAM(3);
    if (IN(4)) { for (int t = blockIdx.x; t < 1024; t += G) ssd_b_tile(args, lds, t, tid, lane, wave); } SEAM(4);
    if (IN(5)) {
        pg8::Gemm g{(const bf16*)(ws + WS_MIX), (const bf16*)(ws + WS_WOUT), MTOK, DM, 2048}; pg8::StaticOrder S; S.init(MTOK, DM, G, (int)blockIdx.x);
        EpiResid E{XB, SSP, nullptr};
        pg8::gemm_phase<EpiResid, pg8::StaticOrder, true, true>(lds, g, S, E);
    } SEAM(5);
    if (IN(6)) {
        pg8::Gemm g{XB, (const bf16*)(ws + WS_WUP0), MTOK, DFF, DM}; pg8::StaticOrder S; S.init(MTOK, DFF, G, (int)blockIdx.x);
        EpiRelu2 E{SSP, (bf16*)(ws + WS_HID)};
        pg8::gemm_phase<EpiRelu2, pg8::StaticOrder, true, true>(lds, g, S, E);
    } SEAM(6);
    if (IN(7)) {
        pg8::Gemm g{(const bf16*)(ws + WS_HID), (const bf16*)(ws + WS_WDN0), MTOK, DM, DFF, HIDP}; pg8::StaticOrder S; S.init(MTOK, DM, G, (int)blockIdx.x);
        EpiResid E{XB, SSP, nullptr};
        pg8::gemm_phase<EpiResid, pg8::StaticOrder, true, true>(lds, g, S, E);
    } SEAM(7);
    if (IN(8)) {
        pg8::Gemm g{XB, (const bf16*)(ws + WS_WQKV), MTOK, QKVD, DM}; pg8::StaticOrder S; S.init(MTOK, QKVD, G, (int)blockIdx.x);
        EpiQKV E{SSP, (bf16*)(ws + WS_QKV), args.in[17]};
        pg8::gemm_phase<EpiQKV, pg8::StaticOrder, true, true>(lds, g, S, E);
    } SEAM(8);
    if (IN(9)) { for (int t = blockIdx.x; t < 512; t += G) attn_tile(args, lds, t, tid, lane, wave); } SEAM(9);
    if (IN(10)) {
        pg8::Gemm g{(const bf16*)(ws + WS_ATT), (const bf16*)(ws + WS_WO), MTOK, DM, DM}; pg8::StaticOrder S; S.init(MTOK, DM, G, (int)blockIdx.x);
        EpiResid E{XB, SSP, args.in[19]};
        pg8::gemm_phase<EpiResid, pg8::StaticOrder, true, true>(lds, g, S, E);
    } SEAM(10);
    if (IN(11)) {
        pg8::Gemm g{XB, (const bf16*)(ws + WS_WUP1), MTOK, DFF, DM}; pg8::StaticOrder S; S.init(MTOK, DFF, G, (int)blockIdx.x);
        EpiRelu2 E{SSP, (bf16*)(ws + WS_HID)};
        pg8::gemm_phase<EpiRelu2, pg8::StaticOrder, true, true>(lds, g, S, E);
    } SEAM(11);
    if (IN(12)) {
        pg8::Gemm g{(const bf16*)(ws + WS_HID), (const bf16*)(ws + WS_WDN1), MTOK, DM, DFF, HIDP}; pg8::StaticOrder S; S.init(MTOK, DM, G, (int)blockIdx.x);
        EpiResid E{XB, SSP, nullptr};
        pg8::gemm_phase<EpiResid, pg8::StaticOrder, true, true>(lds, g, S, E);
    } SEAM(12);
    if (IN(13)) {
        const float* fg = args.in[3];
        f32x4 gv[2][2];
#pragma unroll
        for (int j = 0; j < 2; ++j) { gv[j][0] = *(const f32x4*)(fg + j * 512 + lane * 8); gv[j][1] = *(const f32x4*)(fg + j * 512 + lane * 8 + 4); }
        for (int m = blockIdx.x * 8 + wave; m < MTOK; m += G * 8) {
            f32x4 v[2][2]; float sq = 0.f;
#pragma unroll
            for (int j = 0; j < 2; ++j) { const u32x4 r = *(const u32x4*)(XB + (size_t)m * DM + j * 512 + lane * 8);
                v[j][0] = (f32x4){bflo(r.x), bfhi(r.x), bflo(r.y), bfhi(r.y)}; v[j][1] = (f32x4){bflo(r.z), bfhi(r.z), bflo(r.w), bfhi(r.w)};
#pragma unroll
                for (int k = 0; k < 2; ++k) sq += (v[j][k].x * v[j][k].x + v[j][k].y * v[j][k].y) + (v[j][k].z * v[j][k].z + v[j][k].w * v[j][k].w); }
            const float rs = rsqrtf(wave_sum(sq) * (1.f / 1024.f) + 1e-5f);
#pragma unroll
            for (int j = 0; j < 2; ++j)
#pragma unroll
                for (int k = 0; k < 2; ++k) __builtin_nontemporal_store(v[j][k] * rs * gv[j][k], (f32x4*)(H + (size_t)m * DM + j * 512 + lane * 8 + k * 4));
        }
    }
#ifdef DBG_STOP
    if (lo == 100) {
        const unsigned short* base = (const unsigned short*)(ws + (size_t)DBG_LO * MiB); const size_t n = (size_t)(DBG_HI - DBG_LO) * MiB / 2;
        for (size_t i = (size_t)blockIdx.x * 512 + tid; i < (size_t)MTOK * DM; i += (size_t)G * 512) { float sum = 0.f; for (size_t e = i; e < n; e += (size_t)MTOK * DM) sum += (float)base[e]; args.out[i] = sum; }
    }
#endif
#undef IN
#undef SEAM
}

#ifndef MK_N_LAUNCHES
#define MK_N_LAUNCHES 14
#endif

__global__ void dbg_fill(float* o, size_t n, float v) { for (size_t i = (size_t)blockIdx.x * 256 + threadIdx.x; i < n; i += (size_t)gridDim.x * 256) o[i] = v; }
extern "C" void kernel_launch(void* const* d_in, const int* in_sizes, int n_in, void* d_out, int out_size, void* d_ws, size_t ws_size, hipStream_t stream) {
    static int grid = 0;
    if (grid == 0) {
        if (n_in != 23 || in_sizes[0] != MTOK * DM || out_size != MTOK * DM || ws_size < WS_END) {
            fprintf(stderr, "kernel_launch: unexpected shapes: n_in %d in0 %d out %d ws %zu (need %zu)\n", n_in, n_in > 0 ? in_sizes[0] : -1, out_size, ws_size, (size_t)WS_END); grid = -1; return; }
        int dev = 0, cus = 0, per_cu = 0;
        if (hipGetDevice(&dev) != hipSuccess || hipDeviceGetAttribute(&cus, hipDeviceAttributeMultiprocessorCount, dev) != hipSuccess) { fprintf(stderr, "kernel_launch: device query failed\n"); grid = -1; return; }
        if (hipFuncSetAttribute((const void*)hybrid_fwd, hipFuncAttributeMaxDynamicSharedMemorySize, LDS_BYTES) != hipSuccess) { fprintf(stderr, "kernel_launch: hipFuncSetAttribute failed\n"); grid = -1; return; }
        if (hipOccupancyMaxActiveBlocksPerMultiprocessor(&per_cu, (const void*)hybrid_fwd, 512, LDS_BYTES) != hipSuccess || per_cu < 1) { fprintf(stderr, "kernel_launch: occupancy query says %d\n", per_cu); per_cu = 1; }
        (void)hipGetLastError();
        grid = cus * per_cu;
    }
    if (grid < 0) return;
    if (hipMemsetAsync(d_ws, 0, 16384, stream) != hipSuccess) { fprintf(stderr, "kernel_launch: memset failed\n"); return; }
    Args a{};
    for (int i = 0; i < 23; ++i) a.in[i] = (const float*)d_in[i];
    a.out = (float*)d_out; a.ws = (unsigned char*)d_ws;
#if MK_N_LAUNCHES == 1
    a.ph_lo = 0; a.ph_hi = NPHASE;
    void* kargs[] = {&a};
    hipError_t e = hipLaunchCooperativeKernel((const void*)hybrid_fwd, dim3(grid), dim3(512), kargs, LDS_BYTES, stream);
    if (e != hipSuccess) fprintf(stderr, "kernel_launch: cooperative launch failed: %s (grid %d)\n", hipGetErrorString(e), grid);
#else
#ifdef DBG_STOP
    for (int p = 0; p <= DBG_STOP; ++p) { a.ph_lo = p; a.ph_hi = p + 1; hipLaunchKernelGGL(hybrid_fwd, dim3(grid), dim3(512), LDS_BYTES, stream, a); }
    if (DBG_HI > DBG_LO) { a.ph_lo = 100; a.ph_hi = 101; hipLaunchKernelGGL(hybrid_fwd, dim3(grid), dim3(512), LDS_BYTES, stream, a); }
#else
    for (int p = 0; p < NPHASE; ++p) { a.ph_lo = p; a.ph_hi = p + 1; hipLaunchKernelGGL(hybrid_fwd, dim3(grid), dim3(512), LDS_BYTES, stream, a); }
#endif
#endif
}
```
